# Optimizing an MI355X kernel written in HIP

```python
import jax, jax.numpy as jnp
from jax import lax
import numpy as np

D_MODEL = 1024
BATCH = 2
SEQ = 8192
DEPTH = 2
DEC_BATCH = 8
DEC_SEQ = 8192
PAST_LEN = 128

N_MIXERS = 2
N_ATTN_LAYERS = (DEPTH + 1) // 2
N_POOL_LAYERS = DEPTH // 2
N_HEADS = 8
N_KV_HEADS = 2
HEAD_DIM = 128
GROUP = N_HEADS // N_KV_HEADS
Q_DIM = N_HEADS * HEAD_DIM
KV_DIM = N_KV_HEADS * HEAD_DIM
ATTN_IN = 2 * Q_DIM + 2 * KV_DIM
AXIS_DIM = HEAD_DIM // 2
ROPE_THETA = 10000.0
Q_BLOCK = 128
GRID_W = 64
POOL_WINDOWS = (2, 4, 8, 16)
N_POOL_GROUPS = len(POOL_WINDOWS)
POOL_WIDTH = D_MODEL
POOL_GROUP_WIDTH = POOL_WIDTH // N_POOL_GROUPS
RMS_EPS = 1e-6

kernel_name = "hybrid_axial_gqa_multiscale_pool_encoder"


def _rmsnorm(x, g):
    x32 = x.astype(jnp.float32)
    y = x32 * lax.rsqrt(jnp.mean(x32 * x32, axis=-1, keepdims=True) + RMS_EPS)
    return (y * g.astype(jnp.float32)).astype(x.dtype)


def _axial_rope(s):
    rows = s // GRID_W
    row = jnp.broadcast_to(jnp.arange(rows)[:, None], (rows, GRID_W)).reshape(s).astype(jnp.float32)
    col = jnp.broadcast_to(jnp.arange(GRID_W)[None, :], (rows, GRID_W)).reshape(s).astype(jnp.float32)
    inv = ROPE_THETA ** (-jnp.arange(0, AXIS_DIM, 2, dtype=jnp.float32) / AXIS_DIM)
    ang = jnp.concatenate([row[:, None] * inv, col[:, None] * inv], axis=-1)
    return jnp.cos(ang), jnp.sin(ang)


def _apply_rope(x, cos, sin):
    b, s, h, d = x.shape
    xr = x.reshape(b, s, h, d // 2, 2)
    x0, x1 = xr[..., 0], xr[..., 1]
    c = cos[None, :, None, :]
    sn = sin[None, :, None, :]
    return jnp.stack([x0 * c - x1 * sn, x0 * sn + x1 * c], axis=-1).reshape(b, s, h, d)


def _attention_mixer(h, w_in, q_g, k_g, w_out):
    b, s, _ = h.shape
    q, k, v, gate = jnp.split(h @ w_in, [Q_DIM, Q_DIM + KV_DIM, Q_DIM + 2 * KV_DIM], axis=-1)
    q = q.reshape(b, s, N_HEADS, HEAD_DIM)
    k = k.reshape(b, s, N_KV_HEADS, HEAD_DIM)
    v = v.reshape(b, s, N_KV_HEADS, HEAD_DIM)
    cos, sin = _axial_rope(s)
    q = (_apply_rope(_rmsnorm(q, q_g).astype(jnp.float32), cos, sin) * (HEAD_DIM ** -0.5)).astype(h.dtype)
    k = _apply_rope(_rmsnorm(k, k_g).astype(jnp.float32), cos, sin).astype(h.dtype)
    nb = s // Q_BLOCK
    qb = q.reshape(b, nb, Q_BLOCK, N_KV_HEADS, GROUP, HEAD_DIM).transpose(1, 0, 2, 3, 4, 5)

    def block(qblk):
        sc = jnp.einsum('bqkgd,bskd->bkgqs', qblk, k, preferred_element_type=jnp.float32)
        p = jax.nn.softmax(sc, axis=-1)
        return jnp.einsum('bkgqs,bskd->bqkgd', p.astype(v.dtype), v)

    o = lax.map(block, qb)
    o = o.transpose(1, 0, 2, 3, 4, 5).reshape(b, s, Q_DIM)
    return (o * jax.nn.silu(gate)) @ w_out


def _pool_mixer(h, w_in, w_group, scale, w_out):
    b, s, _ = h.shape
    u, gate = jnp.split(h @ w_in, 2, axis=-1)
    u32 = u.astype(jnp.float32)
    cs = jnp.concatenate([jnp.zeros((b, 1, POOL_WIDTH), jnp.float32), jnp.cumsum(u32, axis=1)], axis=1)
    t = jnp.arange(s)
    pooled = []
    for j, w in enumerate(POOL_WINDOWS):
        lo = jnp.clip(t - w // 2, 0, s)
        hi = jnp.clip(t - w // 2 + w, 0, s)
        csg = cs[..., j * POOL_GROUP_WIDTH:(j + 1) * POOL_GROUP_WIDTH]
        cnt = (hi - lo).astype(jnp.float32)[None, :, None]
        pooled.append((jnp.take(csg, hi, axis=1) - jnp.take(csg, lo, axis=1)) / cnt)
    mix = (jnp.concatenate(pooled, axis=-1) - u32).astype(h.dtype)
    mix = jnp.einsum('bsgc,gcd->bsgd', mix.reshape(b, s, N_POOL_GROUPS, POOL_GROUP_WIDTH), w_group)
    mix = mix.reshape(b, s, POOL_WIDTH) * scale
    return (mix * jax.nn.silu(gate)) @ w_out


def _trunk(x, c, norm_g, ada_w, ada_b, attn_w_in, attn_q_norm, attn_k_norm, attn_w_out,
           pool_w_in, pool_w_group, pool_scale, pool_w_out):
    cs = jax.nn.silu(c)
    for i in range(DEPTH):
        mod = cs @ ada_w[i] + ada_b[i]
        shift, scl, gate = jnp.split(mod, 3, axis=-1)
        h = _rmsnorm(x, norm_g[i]) * (1 + scl[:, None, :]) + shift[:, None, :]
        j = i // N_MIXERS
        if i % N_MIXERS == 0:
            out = _attention_mixer(h, attn_w_in[j], attn_q_norm[j], attn_k_norm[j], attn_w_out[j])
        else:
            out = _pool_mixer(h, pool_w_in[j], pool_w_group[j], pool_scale[j], pool_w_out[j])
        x = x + gate[:, None, :] * out
    return x


def setup_inputs(seed: int = 0) -> dict:
    key = jax.random.key(seed)
    ks = jax.random.split(key, 16)
    f32 = jnp.float32
    nrm = lambda k, shp: jax.random.normal(k, shp, f32)
    return {
        "x_prompt": nrm(ks[0], (BATCH, SEQ, D_MODEL)),
        "x_sample": nrm(ks[1], (DEC_BATCH, DEC_SEQ, D_MODEL)),
        "c_prompt": nrm(ks[2], (BATCH, D_MODEL)),
        "c_sample": nrm(ks[3], (DEC_BATCH, D_MODEL)),
        "norm_g": 1.0 + 0.02 * nrm(ks[4], (DEPTH, D_MODEL)),
        "ada_w": nrm(ks[5], (DEPTH, D_MODEL, 3 * D_MODEL)) * (0.5 * D_MODEL ** -0.5),
        "ada_b": 0.01 * nrm(ks[6], (DEPTH, 3 * D_MODEL)),
        "attn_w_in": nrm(ks[7], (N_ATTN_LAYERS, D_MODEL, ATTN_IN)) * D_MODEL ** -0.5,
        "attn_q_norm": 1.0 + 0.02 * nrm(ks[8], (N_ATTN_LAYERS, HEAD_DIM)),
        "attn_k_norm": 1.0 + 0.02 * nrm(ks[9], (N_ATTN_LAYERS, HEAD_DIM)),
        "attn_w_out": nrm(ks[10], (N_ATTN_LAYERS, Q_DIM, D_MODEL)) * Q_DIM ** -0.5,
        "pool_w_in": nrm(ks[11], (N_POOL_LAYERS, D_MODEL, 2 * POOL_WIDTH)) * D_MODEL ** -0.5,
        "pool_w_group": nrm(ks[12], (N_POOL_LAYERS, N_POOL_GROUPS, POOL_GROUP_WIDTH, POOL_GROUP_WIDTH)) * POOL_GROUP_WIDTH ** -0.5,
        "pool_scale": 1.0 + 0.1 * nrm(ks[13], (N_POOL_LAYERS, POOL_WIDTH)),
        "pool_w_out": nrm(ks[14], (N_POOL_LAYERS, POOL_WIDTH, D_MODEL)) * POOL_WIDTH ** -0.5,
    }


def reference(x_prompt, x_sample, c_prompt, c_sample, norm_g, ada_w, ada_b, attn_w_in,
              attn_q_norm, attn_k_norm, attn_w_out, pool_w_in, pool_w_group, pool_scale, pool_w_out):
    y_prompt = _trunk(x_prompt, c_prompt, norm_g, ada_w, ada_b, attn_w_in, attn_q_norm, attn_k_norm,
                      attn_w_out, pool_w_in, pool_w_group, pool_scale, pool_w_out)
    y_sample = _trunk(x_sample, c_sample, norm_g, ada_w, ada_b, attn_w_in, attn_q_norm, attn_k_norm,
                      attn_w_out, pool_w_in, pool_w_group, pool_scale, pool_w_out)
    return (y_prompt, y_sample)
```

```cpp
#include <hip/hip_runtime.h>
#include <hip/hip_cooperative_groups.h>
#include <cstdio>
#include <cstdint>
namespace cg = cooperative_groups;

#ifndef MK_N_LAUNCHES
#define MK_N_LAUNCHES 1
#endif

constexpr int DM = 1024, SEQ = 8192, NB = 10, NBP = 2, M = NB * SEQ, MP = NBP * SEQ;
constexpr int NH = 8, HD = 128, KVD = 256, N_IN = 2560;
constexpr float RMS_EPS = 1e-6f;
constexpr int NPHASE = 8;
constexpr float QSCALE = 8.0f * 0.088388347648318440f * 1.4426950408889634f;

#define LAS __attribute__((address_space(3)))
typedef unsigned short bf16_t;
typedef short bf16x8 __attribute__((ext_vector_type(8)));
typedef short s16x4 __attribute__((ext_vector_type(4)));
typedef float f32x4 __attribute__((ext_vector_type(4)));
typedef float f32x16 __attribute__((ext_vector_type(16)));
typedef unsigned u32x4 __attribute__((ext_vector_type(4)));
typedef unsigned u32x2 __attribute__((ext_vector_type(2)));

__device__ __forceinline__ unsigned cvt_pk_bf16(float lo, float hi) { unsigned r; asm volatile("v_cvt_pk_bf16_f32 %0, %1, %2" : "=v"(r) : "v"(lo), "v"(hi)); return r; }
__device__ __forceinline__ float bf_lo(unsigned w) { return __uint_as_float(w << 16); }
__device__ __forceinline__ float bf_hi(unsigned w) { return __uint_as_float(w & 0xffff0000u); }
__device__ __forceinline__ int lane_id() { return (int)__builtin_amdgcn_mbcnt_hi(~0u, __builtin_amdgcn_mbcnt_lo(~0u, 0u)); }
__device__ __forceinline__ float sum_fq4(float s) {
    { auto r = __builtin_amdgcn_permlane16_swap(__float_as_uint(s), __float_as_uint(s), false, false); s = __uint_as_float(r[0]) + __uint_as_float(r[1]); }
    { auto r = __builtin_amdgcn_permlane32_swap(__float_as_uint(s), __float_as_uint(s), false, false); s = __uint_as_float(r[0]) + __uint_as_float(r[1]); }
    return s;
}
__device__ __forceinline__ float silu_f(float x) { return x * __builtin_amdgcn_rcpf(1.0f + __builtin_amdgcn_exp2f(-1.4426950408889634f * x)); }

namespace pg8 {
constexpr int BM = 256, BK = 64, HALF = 128, HTB = HALF * BK * 2, STAGE_BYTES = 8 * HTB, NXCD = 8, WGM = 8;

__host__ __device__ __forceinline__ int lds_byte(int r, int c) { const int st = (r >> 4) * 2 + (c >> 5), rr = r & 15, cc = c & 31, ob = rr * 64 + cc * 2; return st * 1024 + (ob ^ (((ob >> 9) & 1) << 5)); }
__host__ __device__ __forceinline__ void stage_rc(int b, int& R, int& C) { const int st = b / 1024, sb = b % 1024, swz = sb ^ (((sb >> 9) & 1) << 5); R = (st >> 1) * 16 + swz / 64; C = (st & 1) * 32 + (swz % 64) / 2; }
__host__ __device__ __forceinline__ int perm32(int rho) { const int n = rho >> 4, i = rho & 15; return 8 * (i >> 2) + 4 * n + (i & 3); }

struct Unit { int pm, pn; };
struct Gemm { const bf16_t* A; const bf16_t* Bt; int M, N, K, lda; size_t apn; };

struct StaticOrder {
    int nM, nN, nwg, G, c;
    __host__ __device__ void init(int M_, int N_, int G_, int c_) { nM = M_ / BM; nN = N_ / BM; nwg = nM * nN; G = G_; c = c_; }
    __host__ __device__ bool next(int i, Unit& u) const {
        const long L = (long)i * G + c; if (L >= nwg) return false;
        int wgid = (int)L; { const int q = nwg / NXCD, r = nwg % NXCD, xcd = wgid % NXCD, off = wgid / NXCD; wgid = (xcd < r ? xcd * (q + 1) : r * (q + 1) + (xcd - r) * q) + off; }
        const int nig = WGM * nN, gid = wgid / nig, fm = gid * WGM, gsz = (nM - fm) < WGM ? (nM - fm) : WGM;
        u.pm = fm + ((wgid % nig) % gsz); u.pn = (wgid % nig) / gsz; return true;
    }
};


struct EpiPoolIn {
    static constexpr bool PERM = true;
    bf16_t* Z; bf16_t* G2; const float* rowss; const float* sw;
    __device__ __forceinline__ void operator()(const f32x4 (&acc)[2][2][4][2], const Unit& u, int wr, int wc, int fr, int fq) const {
        const int row0 = u.pm * BM + wr * 64 + fr, b = (u.pm * BM) / SEQ;
        const float* swp = sw + (size_t)b * 2048 + u.pn * BM + wc * 32 + 8 * fq;
        bf16_t* base = ((u.pn < 4) ? Z : G2) + (u.pn & 3) * BM + wc * 32 + 8 * fq;
        float rs[2][4]; f32x4 s4[2][2];
#pragma unroll
        for (int ai = 0; ai < 2; ++ai)
#pragma unroll
            for (int m = 0; m < 4; ++m) rs[ai][m] = rowss[row0 + ai * HALF + m * 16];
#pragma unroll
        for (int bj = 0; bj < 2; ++bj) { s4[bj][0] = *(const f32x4*)(swp + bj * HALF); s4[bj][1] = *(const f32x4*)(swp + bj * HALF + 4); }
#pragma unroll
        for (int ai = 0; ai < 2; ++ai)
#pragma unroll
            for (int m = 0; m < 4; ++m) { const int row = row0 + ai * HALF + m * 16; const float r_ = __builtin_amdgcn_rsqf(rs[ai][m] * (1.0f / DM) + RMS_EPS);
                bf16_t* rowp = base + (size_t)row * DM;
#pragma unroll
                for (int bj = 0; bj < 2; ++bj) { const f32x4 v0 = acc[ai][bj][m][0] * r_ + s4[bj][0], v1 = acc[ai][bj][m][1] * r_ + s4[bj][1];
                    u32x4 w; w.x = cvt_pk_bf16(v0[0], v0[1]); w.y = cvt_pk_bf16(v0[2], v0[3]); w.z = cvt_pk_bf16(v1[0], v1[1]); w.w = cvt_pk_bf16(v1[2], v1[3]);
                    *(u32x4*)(rowp + bj * HALF) = w; } }
    }
};

struct EpiQKVG {
    static constexpr bool PERM = true;
    unsigned char *Q, *Kb, *V; bf16_t* G; const float* qg; const float* kg; const float* rope; LAS float* X;
    __device__ __forceinline__ void operator()(const f32x4 (&acc)[2][2][4][2], const Unit& u, int wr, int wc, int fr, int fq) const {
        const int hc = wc * 32 + 8 * fq;
        if (u.pn <= 4) {
#pragma unroll
            for (int ai = 0; ai < 2; ++ai)
#pragma unroll
                for (int m = 0; m < 4; ++m)
#pragma unroll
                    for (int bj = 0; bj < 2; ++bj) { const f32x4 a = acc[ai][bj][m][0], b = acc[ai][bj][m][1];
                        float s = (a[0] * a[0] + a[1] * a[1]) + (a[2] * a[2] + a[3] * a[3]) + (b[0] * b[0] + b[1] * b[1]) + (b[2] * b[2] + b[3] * b[3]);
                        s = sum_fq4(s);
                        if (fq == 0) X[((ai * HALF + wr * 64 + m * 16 + fr) * 2 + bj) * 4 + wc] = s; }
            asm volatile("s_waitcnt lgkmcnt(0)" ::: "memory"); __builtin_amdgcn_s_barrier(); asm volatile("" ::: "memory");
            const float* gsrc = (u.pn < 4) ? qg : kg;
            const f32x4 g0 = *(const f32x4*)(gsrc + hc), g1 = *(const f32x4*)(gsrc + hc + 4);
            unsigned char* base; int ldc, colt;
            if (u.pn < 4) { base = Q; ldc = DM; colt = u.pn * BM; } else { base = Kb; ldc = KVD; colt = 0; }
#pragma unroll
            for (int ai = 0; ai < 2; ++ai)
#pragma unroll
                for (int m = 0; m < 4; ++m) { const int lr = ai * HALF + wr * 64 + m * 16 + fr, row = u.pm * BM + lr, spos = row & (SEQ - 1);
                    const f32x4* rp = (const f32x4*)(rope + (size_t)spos * 128 + hc); const f32x4 r0 = rp[0], r1 = rp[1];
#pragma unroll
                    for (int bj = 0; bj < 2; ++bj) { const f32x4 sv = *(const LAS f32x4*)(X + (lr * 2 + bj) * 4);
                        const float rs = __builtin_amdgcn_rsqf(((sv[0] + sv[1]) + (sv[2] + sv[3])) * (1.0f / 128.0f) + RMS_EPS) * (u.pn < 4 ? QSCALE : 1.0f);
                        const f32x4 a = acc[ai][bj][m][0] * rs * g0, b = acc[ai][bj][m][1] * rs * g1;
                        u32x2 w; int t0, t1;
                        t0 = __builtin_amdgcn_cvt_pk_fp8_f32(a[0] * r0[0] - a[1] * r0[1], a[0] * r0[1] + a[1] * r0[0], 0, false);
                        t0 = __builtin_amdgcn_cvt_pk_fp8_f32(a[2] * r0[2] - a[3] * r0[3], a[2] * r0[3] + a[3] * r0[2], t0, true);
                        t1 = __builtin_amdgcn_cvt_pk_fp8_f32(b[0] * r1[0] - b[1] * r1[1], b[0] * r1[1] + b[1] * r1[0], 0, false);
                        t1 = __builtin_amdgcn_cvt_pk_fp8_f32(b[2] * r1[2] - b[3] * r1[3], b[2] * r1[3] + b[3] * r1[2], t1, true);
                        w.x = (unsigned)t0; w.y = (unsigned)t1;
                        *(u32x2*)(base + (size_t)row * ldc + colt + bj * HALF + hc) = w; } }
        } else if (u.pn == 5) {
            const int row0 = u.pm * BM + wr * 64 + fr, b = (u.pm * BM) / SEQ;
#pragma unroll
            for (int ai = 0; ai < 2; ++ai)
#pragma unroll
                for (int m = 0; m < 4; ++m) { const int row = row0 + ai * HALF + m * 16, sp = row & (SEQ - 1);
#pragma unroll
                    for (int bj = 0; bj < 2; ++bj) { const f32x4 v0 = acc[ai][bj][m][0], v1 = acc[ai][bj][m][1];
                        const int kk = sp & 63, kq = kk >> 4, kr = kk & 15, oA = ((kq ^ ((2 * fq) & 3)) << 4) + kr, oB = ((kq ^ ((2 * fq + 1) & 3)) << 4) + kr;
                        unsigned char* vp = V + ((size_t)((b * 2 + bj) * 128 + (sp >> 6)) * 8192 + (size_t)hc * 64);
                        int t0 = __builtin_amdgcn_cvt_pk_fp8_f32(v0[0], v0[1], 0, false); t0 = __builtin_amdgcn_cvt_pk_fp8_f32(v0[2], v0[3], t0, true);
                        int t1 = __builtin_amdgcn_cvt_pk_fp8_f32(v1[0], v1[1], 0, false); t1 = __builtin_amdgcn_cvt_pk_fp8_f32(v1[2], v1[3], t1, true);
                        vp[oA] = (unsigned char)t0; vp[64 + oA] = (unsigned char)(t0 >> 8); vp[128 + oA] = (unsigned char)(t0 >> 16); vp[192 + oA] = (unsigned char)((unsigned)t0 >> 24);
                        vp[256 + oB] = (unsigned char)t1; vp[320 + oB] = (unsigned char)(t1 >> 8); vp[384 + oB] = (unsigned char)(t1 >> 16); vp[448 + oB] = (unsigned char)((unsigned)t1 >> 24); }
                    asm volatile("" ::: "memory"); }
        } else {
            bf16_t* base = G; const int ldc = DM, colt = (u.pn - 6) * BM;
            const int row0 = u.pm * BM + wr * 64 + fr;
#pragma unroll
            for (int ai = 0; ai < 2; ++ai)
#pragma unroll
                for (int m = 0; m < 4; ++m) { bf16_t* rowp = base + (size_t)(row0 + ai * HALF + m * 16) * ldc + colt + hc;
#pragma unroll
                    for (int bj = 0; bj < 2; ++bj) { const f32x4 v0 = acc[ai][bj][m][0], v1 = acc[ai][bj][m][1];
                        u32x4 w; w.x = cvt_pk_bf16(v0[0], v0[1]); w.y = cvt_pk_bf16(v0[2], v0[3]); w.z = cvt_pk_bf16(v1[0], v1[1]); w.w = cvt_pk_bf16(v1[2], v1[3]);
                        *(u32x4*)(rowp + bj * HALF) = w; } }
        }
    }
};

struct EpiResGate {
    static constexpr bool PERM = false;
    const float* xa; const float* xb; float* out; const float* mod; int layer;
    __device__ __forceinline__ void operator()(const f32x4 (&acc)[2][2][4][2], const Unit& u, int wr, int wc, int fr, int fq) const {
        const int row0 = u.pm * BM + wr * 64 + fr, b = (u.pm * BM) / SEQ;
        const int col0 = u.pn * BM + wc * 32 + 4 * fq;
        const float* gt = mod + (size_t)(b * 2 + layer) * 3072 + 2048 + col0;
        f32x4 gv[2][2];
#pragma unroll
        for (int bj = 0; bj < 2; ++bj)
#pragma unroll
            for (int n = 0; n < 2; ++n) gv[bj][n] = *(const f32x4*)(gt + bj * HALF + n * 16);
#pragma unroll
        for (int ai = 0; ai < 2; ++ai) { f32x4 xv[4][2][2];
#pragma unroll
            for (int m = 0; m < 4; ++m) { const int row = row0 + ai * HALF + m * 16;
                const float* xr = (row < MP ? xa + (size_t)row * DM : xb + (size_t)(row - MP) * DM) + col0;
#pragma unroll
                for (int bj = 0; bj < 2; ++bj)
#pragma unroll
                    for (int n = 0; n < 2; ++n) xv[m][bj][n] = *(const f32x4*)(xr + bj * HALF + n * 16); }
#pragma unroll
            for (int m = 0; m < 4; ++m) { float* orow = out + (size_t)(row0 + ai * HALF + m * 16) * DM + col0;
#pragma unroll
                for (int bj = 0; bj < 2; ++bj)
#pragma unroll
                    for (int n = 0; n < 2; ++n) *(f32x4*)(orow + bj * HALF + n * 16) = xv[m][bj][n] + gv[bj][n] * acc[ai][bj][m][n]; }
            asm volatile("" ::: "memory"); }
    }
};

struct EpiX1 {
    static constexpr bool PERM = false;
    const float* xa; const float* xb; float* out; bf16_t* X1A; const float* mod; const float* g1; float* rowss;
    __device__ __forceinline__ void operator()(const f32x4 (&acc)[2][2][4][2], const Unit& u, int wr, int wc, int fr, int fq) const {
        const int row0 = u.pm * BM + wr * 64 + fr, b = (u.pm * BM) / SEQ;
        const int col0 = u.pn * BM + wc * 32 + 4 * fq;
        const float* gt = mod + (size_t)(b * 2 + 0) * 3072 + 2048 + col0;
        const float* sc1 = mod + (size_t)(b * 2 + 1) * 3072 + 1024 + col0;
        f32x4 gv[2][2], av[2][2];
#pragma unroll
        for (int bj = 0; bj < 2; ++bj)
#pragma unroll
            for (int n = 0; n < 2; ++n) { gv[bj][n] = *(const f32x4*)(gt + bj * HALF + n * 16);
                av[bj][n] = *(const f32x4*)(g1 + col0 + bj * HALF + n * 16) * (*(const f32x4*)(sc1 + bj * HALF + n * 16) + 1.0f); }
#pragma unroll
        for (int ai = 0; ai < 2; ++ai)
#pragma unroll
            for (int mp = 0; mp < 2; ++mp) { f32x4 xv[2][2][2];
#pragma unroll
                for (int mm = 0; mm < 2; ++mm) { const int row = row0 + ai * HALF + (2 * mp + mm) * 16;
                    const float* xr = (row < MP ? xa + (size_t)row * DM : xb + (size_t)(row - MP) * DM) + col0;
#pragma unroll
                    for (int bj = 0; bj < 2; ++bj)
#pragma unroll
                        for (int n = 0; n < 2; ++n) xv[mm][bj][n] = *(const f32x4*)(xr + bj * HALF + n * 16); }
#pragma unroll
                for (int mm = 0; mm < 2; ++mm) { const int m = 2 * mp + mm, row = row0 + ai * HALF + m * 16;
                    float* orow = out + (size_t)row * DM + col0; bf16_t* arow = X1A + (size_t)row * DM + col0; float ss = 0.f;
#pragma unroll
                    for (int bj = 0; bj < 2; ++bj)
#pragma unroll
                        for (int n = 0; n < 2; ++n) { const f32x4 o = xv[mm][bj][n] + gv[bj][n] * acc[ai][bj][m][n];
                            *(f32x4*)(orow + bj * HALF + n * 16) = o; ss += (o[0] * o[0] + o[1] * o[1]) + (o[2] * o[2] + o[3] * o[3]);
                            const f32x4 y = o * av[bj][n]; u32x2 w; w.x = cvt_pk_bf16(y[0], y[1]); w.y = cvt_pk_bf16(y[2], y[3]); *(u32x2*)(arow + bj * HALF + n * 16) = w; }
                    ss = sum_fq4(ss);
                    if (fq == 0) (void)__hip_atomic_fetch_add(rowss + row, ss, __ATOMIC_RELAXED, __HIP_MEMORY_SCOPE_AGENT); }
                asm volatile("" ::: "memory"); }
    }
};

template <class Epi, class Sched>
__device__ __forceinline__ void gemm_phase(LAS unsigned char* lds, const Gemm g, const Sched& S, const Epi& E, const int wid) {
    const int lane = lane_id(), tid = wid * 64 + lane, wr = wid >> 2, wc = wid & 3, fr = lane & 15, fq = lane >> 4;
    const int K = g.K, nt = K / BK;
    unsigned voffA[2], voffB[2];
#pragma unroll
    for (int i = 0; i < 2; ++i) { int R, C; stage_rc(tid * 16 + i * 8192, R, C); const int Rb = Epi::PERM ? ((R & ~31) + perm32(R & 31)) : R;
        voffA[i] = (unsigned)(R * g.lda + C) * 2u; voffB[i] = (unsigned)(Rb * K + C) * 2u; }
    const size_t kstep = (size_t)(BK * 2);
    const size_t hstepA = (size_t)HALF * g.lda * 2, hstepB = (size_t)HALF * K * 2;
    const size_t tstepA = 2 * hstepA, tstepB = 2 * hstepB;
    const unsigned ldsw = (unsigned)wid * 1024u;
    const int aoff = lds_byte(wr * 64 + fr, fq * 8), boff = lds_byte(wc * 32 + fr, fq * 8);
#define PG8_SA(b, h) (((b) * 2 + (h)) * HTB)
#define PG8_SB(b, h) ((4 + (b) * 2 + (h)) * HTB)
#define PG8_STAGE(bufoff, gbase, voff) do { _Pragma("unroll") for (int _i = 0; _i < 2; ++_i) \
        __builtin_amdgcn_global_load_lds((const unsigned*)((const char*)(gbase) + (voff)[_i]), (LAS unsigned*)(lds + (bufoff) + ldsw + _i * 8192), 16, 0, 0); } while (0)
#define PG8_LDA(dst, b, h) do { _Pragma("unroll") for (int m = 0; m < 4; ++m) _Pragma("unroll") for (int k = 0; k < 2; ++k) dst[m][k] = *(const LAS bf16x8*)(lds + PG8_SA(b, h) + aoff + m * 2048 + k * 1024); } while (0)
#define PG8_LDB(dst, b, h) do { _Pragma("unroll") for (int n = 0; n < 2; ++n) _Pragma("unroll") for (int k = 0; k < 2; ++k) dst[n][k] = *(const LAS bf16x8*)(lds + PG8_SB(b, h) + boff + n * 2048 + k * 1024); } while (0)
#define PG8_MMA(ai, bj, At, Bt) do { __builtin_amdgcn_s_setprio(1); _Pragma("unroll") for (int m = 0; m < 4; ++m) _Pragma("unroll") for (int n = 0; n < 2; ++n) _Pragma("unroll") for (int k = 0; k < 2; ++k) \
        acc[ai][bj][m][n] = __builtin_amdgcn_mfma_f32_16x16x32_bf16(Bt[n][k], At[m][k], acc[ai][bj][m][n], 0, 0, 0); __builtin_amdgcn_s_setprio(0); } while (0)
#define PG8_WAIT_V(n) asm volatile("s_waitcnt vmcnt(" #n ")" ::: "memory")
#define PG8_WAIT_L(n) asm volatile("s_waitcnt lgkmcnt(" #n ")" ::: "memory")
#define PG8_BAR __builtin_amdgcn_s_barrier()
#define PG8_SCHED __builtin_amdgcn_sched_barrier(0)
    Unit cur, nxt; int ui = 0;
    if (!S.next(0, cur)) return;
    f32x4 acc[2][2][4][2];
#pragma unroll
    for (int a = 0; a < 2; ++a)
#pragma unroll
        for (int b = 0; b < 2; ++b)
#pragma unroll
            for (int m = 0; m < 4; ++m)
#pragma unroll
                for (int n = 0; n < 2; ++n) acc[a][b][m][n] = (f32x4){0.f, 0.f, 0.f, 0.f};
    bf16x8 At[4][2], B0[2][2], B1[2][2];
    const char* cA = (const char*)g.A + (size_t)cur.pm * tstepA + (size_t)cur.pn * g.apn; const char* cB = (const char*)g.Bt + (size_t)cur.pn * tstepB;
    PG8_STAGE(PG8_SB(0, 0), cB, voffB); PG8_STAGE(PG8_SB(0, 1), cB + hstepB, voffB); PG8_STAGE(PG8_SA(0, 0), cA, voffA); PG8_STAGE(PG8_SA(0, 1), cA + hstepA, voffA);
    if (wr == 1) PG8_BAR;
    PG8_WAIT_V(2); PG8_BAR;
    PG8_STAGE(PG8_SB(1, 0), cB + kstep, voffB); PG8_STAGE(PG8_SA(1, 0), cA + kstep, voffA); PG8_STAGE(PG8_SB(1, 1), cB + hstepB + kstep, voffB);
    PG8_WAIT_V(6); PG8_BAR;
    for (;;) {
        const bool has_next = S.next(ui + 1, nxt);
        const char* nA = has_next ? (const char*)g.A + (size_t)nxt.pm * tstepA + (size_t)nxt.pn * g.apn : cA; const char* nB = has_next ? (const char*)g.Bt + (size_t)nxt.pn * tstepB : cB;
        for (int t = 0; t < nt; t += 2) {
            const bool last = (t == nt - 2);
            const char* a1 = cA + (size_t)(t + 1) * kstep;
            const char* a2 = last ? nA : cA + (size_t)(t + 2) * kstep; const char* b2 = last ? nB : cB + (size_t)(t + 2) * kstep;
            const char* a3 = a2 + kstep; const char* b3 = b2 + kstep;
            PG8_LDB(B0, 0, 0); PG8_LDB(B1, 0, 1); PG8_SCHED; PG8_LDA(At, 0, 0); PG8_STAGE(PG8_SA(1, 1), a1 + hstepA, voffA);
            PG8_WAIT_V(8); PG8_WAIT_L(0); PG8_BAR; PG8_MMA(0, 0, At, B0); PG8_MMA(0, 1, At, B1); PG8_BAR; PG8_SCHED;
            PG8_LDA(At, 0, 1); PG8_STAGE(PG8_SB(0, 0), b2, voffB); PG8_STAGE(PG8_SB(0, 1), b2 + hstepB, voffB); PG8_STAGE(PG8_SA(0, 0), a2, voffA);
            PG8_WAIT_V(8); PG8_WAIT_L(0); PG8_BAR; PG8_MMA(1, 0, At, B0); PG8_MMA(1, 1, At, B1); PG8_BAR; PG8_SCHED;
            PG8_LDB(B0, 1, 0); PG8_LDB(B1, 1, 1); PG8_SCHED; PG8_LDA(At, 1, 0); PG8_STAGE(PG8_SA(0, 1), a2 + hstepA, voffA);
            PG8_WAIT_V(8); PG8_WAIT_L(0); PG8_BAR; PG8_MMA(0, 0, At, B0); PG8_MMA(0, 1, At, B1); PG8_BAR; PG8_SCHED;
            PG8_LDA(At, 1, 1); PG8_STAGE(PG8_SB(1, 0), b3, voffB); PG8_STAGE(PG8_SB(1, 1), b3 + hstepB, voffB); PG8_STAGE(PG8_SA(1, 0), a3, voffA);
            PG8_WAIT_V(8); PG8_WAIT_L(0); PG8_BAR; PG8_MMA(1, 0, At, B0); PG8_MMA(1, 1, At, B1); PG8_BAR; PG8_SCHED;
        }
        if (wr == 0) PG8_BAR;
        E(acc, cur, wr, wc, fr, fq);
        if (!has_next) break;
#pragma unroll
        for (int a = 0; a < 2; ++a)
#pragma unroll
            for (int b = 0; b < 2; ++b)
#pragma unroll
                for (int m = 0; m < 4; ++m)
#pragma unroll
                    for (int n = 0; n < 2; ++n) acc[a][b][m][n] = (f32x4){0.f, 0.f, 0.f, 0.f};
        cur = nxt; cA = nA; cB = nB; ++ui;
        if (wr == 1) PG8_BAR;
    }
    PG8_WAIT_V(0);
    PG8_BAR;
#undef PG8_SA
#undef PG8_SB
#undef PG8_STAGE
#undef PG8_LDA
#undef PG8_LDB
#undef PG8_MMA
#undef PG8_WAIT_V
#undef PG8_WAIT_L
#undef PG8_BAR
#undef PG8_SCHED
}
}

#define SBAR() __builtin_amdgcn_sched_barrier(0)

namespace att8 {
typedef int v8i __attribute__((ext_vector_type(8)));
constexpr int NW = 8, QBLK = 32, KVBLK = 64;
constexpr float SCALE = 0.088388347648318440f;
constexpr float THR = 2.f;
constexpr float PSHIFT = 5.f;
constexpr float THR2 = THR * 1.4426950408889634f;
constexpr int LDO = DM;
constexpr int SHM_T = 8192, K_OFF = 4 * SHM_T, WS_OFF = 8 * SHM_T, ST_OFF = WS_OFF + NW * 64 * 4, ST_ROW = 272;
static_assert(ST_OFF + NW * QBLK * ST_ROW <= 147456, "attention LDS");
#define SCL1 0x7F7F7F7F
#define MFMA8(A, B, C) __builtin_amdgcn_mfma_scale_f32_32x32x64_f8f6f4(A, B, C, 0, 0, 0, SCL1, 0, SCL1)
#define MFMA8Q(A, B, C) __builtin_amdgcn_mfma_scale_f32_32x32x64_f8f6f4(A, B, C, 0, 0, 0, SCL1, 0, 0x7C7C7C7C)
__device__ __forceinline__ int crow(int r, int hi) { return (r & 3) + 8 * (r >> 2) + 4 * hi; }
__device__ __forceinline__ v8i ld32(const char* p0, const char* p1) { const u32x4 a = *(const u32x4*)p0, b = *(const u32x4*)p1; return (v8i){(int)a.x, (int)a.y, (int)a.z, (int)a.w, (int)b.x, (int)b.y, (int)b.z, (int)b.w}; }

__device__ __forceinline__ float max32(const f32x16& p0, const f32x16& p1) {
  float m = p0[0]; for (int r = 1; r < 16; ++r) m = fmaxf(m, p0[r]); for (int r = 0; r < 16; ++r) m = fmaxf(m, p1[r]);
  { auto rr = __builtin_amdgcn_permlane32_swap(__float_as_uint(m), __float_as_uint(m), false, false);
    m = fmaxf(__uint_as_float(rr[0]), __uint_as_float(rr[1])); }
  return m;
}
__device__ __forceinline__ void adjustSM(f32x16& p0, f32x16& p1, f32x16& nm, float& alpha, const float pmax) {
  alpha = 1.f;
  if (__builtin_expect(__any(pmax > PSHIFT + THR2), 0)) {
    const float delta = (pmax > PSHIFT + THR2) ? (pmax - PSHIFT) : 0.f;
    alpha = __builtin_amdgcn_exp2f(-delta);
    for (int r = 0; r < 16; ++r) { p0[r] -= delta; p1[r] -= delta; nm[r] -= delta; }
  }
}
__device__ __forceinline__ void exp16(f32x16& p0) { for (int r = 0; r < 16; ++r) p0[r] = __builtin_amdgcn_exp2f(p0[r]); }
__device__ __forceinline__ void partialSM_first(f32x16& p0, f32x16& p1, f32x16& nm) {
  const float delta = max32(p0, p1) - PSHIFT;
  for (int r = 0; r < 16; ++r) { p0[r] -= delta; p1[r] -= delta; nm[r] -= delta; }
  for (int r = 0; r < 16; ++r) p0[r] = __builtin_amdgcn_exp2f(p0[r]);
}
__device__ __forceinline__ void finishSM(f32x16& p0, f32x16& p1, v8i& pf) {
  for (int r = 0; r < 16; ++r) p1[r] = __builtin_amdgcn_exp2f(p1[r]);
#pragma unroll
  for (int j = 0; j < 4; ++j) {
    int a = __builtin_amdgcn_cvt_pk_fp8_f32(p0[4 * j], p0[4 * j + 1], 0, false); a = __builtin_amdgcn_cvt_pk_fp8_f32(p0[4 * j + 2], p0[4 * j + 3], a, true);
    int b = __builtin_amdgcn_cvt_pk_fp8_f32(p1[4 * j], p1[4 * j + 1], 0, false); b = __builtin_amdgcn_cvt_pk_fp8_f32(p1[4 * j + 2], p1[4 * j + 3], b, true);
    auto rr = __builtin_amdgcn_permlane32_swap((unsigned)a, (unsigned)b, false, false);
    pf[2 * j] = (int)rr[0]; pf[2 * j + 1] = (int)rr[1]; }
}
__device__ __forceinline__ void qkt(f32x16& p0, f32x16& p1, const f32x16& nm, const char* Ks, const v8i* qr, int ko, int c00, int c01, int c10, int c11) {
  { const v8i a0 = ld32(Ks + ko + c00, Ks + ko + c01), a1 = ld32(Ks + 4096 + ko + c00, Ks + 4096 + ko + c01);
    p0 = MFMA8Q(a0, qr[0], nm); p1 = MFMA8Q(a1, qr[0], nm); }
  { const v8i a0 = ld32(Ks + ko + c10, Ks + ko + c11), a1 = ld32(Ks + 4096 + ko + c10, Ks + 4096 + ko + c11);
    p0 = MFMA8Q(a0, qr[1], p0); p1 = MFMA8Q(a1, qr[1], p1); }
}
__device__ __forceinline__ void pv_load(v8i* vf, const char* Vs, int vo, int e0, int e1) {
#pragma unroll
  for (int d0 = 0; d0 < 4; ++d0) vf[d0] = ld32(Vs + d0 * 2048 + vo + e0, Vs + d0 * 2048 + vo + e1);
}
__device__ __forceinline__ void pv_mma(f32x16* o, f32x16& ls, const v8i* vf, const v8i pf) {
#pragma unroll
  for (int d0 = 0; d0 < 4; ++d0) o[d0] = MFMA8(pf, vf[d0], o[d0]);
  const v8i ones = {0x38383838, 0x38383838, 0x38383838, 0x38383838, 0x38383838, 0x38383838, 0x38383838, 0x38383838};
  ls = MFMA8(pf, ones, ls);
}

__device__ __forceinline__ void load_q(v8i (&qr)[2], const unsigned char* Q8b, int wid, int r32, int hi) {
  const char* Qw = (const char*)Q8b + (wid * QBLK + r32) * 1024 + hi * 32;
#pragma unroll
  for (int c = 0; c < 2; ++c) { const u32x4 a = *(const u32x4*)(Qw + c * 64), b = *(const u32x4*)(Qw + c * 64 + 16); qr[c] = (v8i){(int)a.x, (int)a.y, (int)a.z, (int)a.w, (int)b.x, (int)b.y, (int)b.z, (int)b.w}; }
}
__device__ __forceinline__ void body(const unsigned char* Q8b, const unsigned char* K8h, const unsigned char* VT8h, const bf16_t* Gb, bf16_t* Ob, int seq, char* lds, const int wid,
                                     v8i (&qr)[2], const int pre, const int nxt, const unsigned char* Q8n, const unsigned char* K8n, const unsigned char* VT8n) {
  const int lane = lane_id(), tid = wid * 64 + lane, r32 = lane & 31, hi = lane >> 5;
  char* V_lds = lds; char* K_lds = lds + K_OFF;
  float* ws = (float*)(lds + WS_OFF) + wid * 64; float* al_l = ws + 32;
  f32x16 o[4] = {}; f32x16 ls = {}; f32x16 nm;
#pragma unroll
  for (int r = 0; r < 16; ++r) nm[r] = PSHIFT;
  LAS char* L3 = (LAS char*)lds;
  const int krow = wid * 8 + (lane >> 3), kc = (lane & 7) ^ ((krow >> 1) & 7);
  const char* Kg = (const char*)K8h + krow * 256 + kc * 16; const char* Vg = (const char*)VT8h + wid * 1024 + lane * 16;
  const int ksw = (r32 >> 1) & 7, ko = r32 * 128, c00 = ((0 + hi * 2) ^ ksw) << 4, c01 = ((1 + hi * 2) ^ ksw) << 4, c10 = ((4 + hi * 2) ^ ksw) << 4, c11 = ((5 + hi * 2) ^ ksw) << 4;
  const int vsw = (r32 >> 2) & 3, vo = r32 * 64, e0 = ((2 * hi) ^ vsw) << 4, e1 = ((2 * hi + 1) ^ vsw) << 4;
#define DMA(slot, t) do { \
    __builtin_amdgcn_global_load_lds((const unsigned*)(Kg + (long)(t) * (64 * 256)), (LAS unsigned*)(L3 + K_OFF + (slot) * SHM_T + wid * 1024), 16, 0, 0); \
    __builtin_amdgcn_global_load_lds((const unsigned*)(Vg + (long)(t) * 8192), (LAS unsigned*)(L3 + (slot) * SHM_T + wid * 1024), 16, 0, 0); } while (0)
#define BAR() do { asm volatile("s_waitcnt lgkmcnt(0)" ::: "memory"); __builtin_amdgcn_s_barrier(); asm volatile("" ::: "memory"); } while (0)
#define WAITV(n) asm volatile("s_waitcnt vmcnt(" #n ")" ::: "memory")
#define RESC(a) do { if (__any((a) < 1.f)) { if (hi == 0) al_l[r32] = (a); asm volatile("s_waitcnt lgkmcnt(0)" ::: "memory"); \
    for (int r = 0; r < 16; ++r) { const float a_ = al_l[crow(r, hi)]; ls[r] *= a_; for (int d = 0; d < 4; ++d) o[d][r] *= a_; } } } while (0)
#define QKT(P0, P1, b) qkt(P0, P1, nm, K_lds + (b) * SHM_T, qr, ko, c00, c01, c10, c11)
#define SGB(mask, n) __builtin_amdgcn_sched_group_barrier(mask, n, 0)
#define PVL(b) pv_load(vf, V_lds + (b) * SHM_T, vo, e0, e1)
#define PVM() pv_mma(o, ls, vf, pf)
#define PIPE1() do { SGB(0x100, 8); SGB(0x400, 4); SGB(0x008, 1); SGB(0x400, 4); SGB(0x008, 1); SGB(0x400, 4); SGB(0x008, 1); SGB(0x400, 4); SGB(0x008, 1); } while (0)
#define HALF2(Y0, Y1, alY, b) do { PVL(b); const float pm_ = max32(Y0, Y1); adjustSM(Y0, Y1, nm, alY, pm_); SBAR(); \
    PVM(); exp16(Y0); asm volatile("" : "+v"(Y0)); \
    SGB(0x008, 1); SGB(0x400, 3); SGB(0x008, 1); SGB(0x400, 3); SGB(0x008, 1); SGB(0x400, 3); SGB(0x008, 1); SGB(0x400, 3); SGB(0x008, 1); SGB(0x400, 4); SBAR(); } while (0)
  f32x16 pA0, pA1, pB0, pB1; float alA, alB; v8i pf; v8i vf[4]; const int NT = seq / KVBLK;
  if (!pre) { DMA(0, 0); DMA(1, 1); } else BAR();
  DMA(2, 2);
  WAITV(2); BAR();
  QKT(pA0, pA1, 0); partialSM_first(pA0, pA1, nm);
  int s0 = 0;
  for (int i = 0; i + 2 < NT; i += 2) {
    SBAR(); QKT(pB0, pB1, (s0 + 1) & 3);
    finishSM(pA0, pA1, pf); PIPE1(); SBAR();
    DMA((s0 + 3) & 3, i + 3);
    SBAR();
    HALF2(pB0, pB1, alB, s0);
    WAITV(2);
    RESC(alB); BAR();
    SBAR(); QKT(pA0, pA1, (s0 + 2) & 3);
    finishSM(pB0, pB1, pf); PIPE1(); SBAR();
    { const int t4 = (i + 4 < NT) ? i + 4 : NT - 1; DMA(s0, t4); }
    SBAR();
    HALF2(pA0, pA1, alA, (s0 + 1) & 3);
    WAITV(2);
    RESC(alA); BAR();
    s0 = (s0 + 2) & 3;
  }
  SBAR(); QKT(pB0, pB1, (s0 + 1) & 3);
  finishSM(pA0, pA1, pf); SBAR();
  HALF2(pB0, pB1, alB, s0);
  RESC(alB);
  PVL((s0 + 1) & 3); finishSM(pB0, pB1, pf); SBAR();
  PVM();
  WAITV(0);
  if (nxt) {
    load_q(qr, Q8n, wid, r32, hi);
    const char* KgN = (const char*)K8n + krow * 256 + kc * 16; const char* VgN = (const char*)VT8n + wid * 1024 + lane * 16;
#pragma unroll
    for (int tn = 0; tn < 2; ++tn) {
      __builtin_amdgcn_global_load_lds((const unsigned*)(KgN + (long)tn * (64 * 256)), (LAS unsigned*)(L3 + K_OFF + tn * SHM_T + wid * 1024), 16, 0, 0);
      __builtin_amdgcn_global_load_lds((const unsigned*)(VgN + (long)tn * 8192), (LAS unsigned*)(L3 + tn * SHM_T + wid * 1024), 16, 0, 0); }
  }
  float rli[16];
#pragma unroll
  for (int r = 0; r < 16; ++r) rli[r] = __builtin_amdgcn_rcpf(ls[r]);
  const int rw = lane >> 4, ch = lane & 15;
  const bf16_t* Gw = Gb + (wid * QBLK + rw) * LDO + ch * 8; bf16_t* Ow = Ob + (wid * QBLK + rw) * LDO + ch * 8;
  u32x4 gv[8];
#pragma unroll
  for (int i = 0; i < 8; ++i) gv[i] = *(const u32x4*)(Gw + i * 4 * LDO);
  char* st = lds + ST_OFF + wid * (QBLK * ST_ROW) + r32 * 2 + hi * 4 * ST_ROW;
#pragma unroll
  for (int r = 0; r < 16; ++r) {
#pragma unroll
    for (int d0 = 0; d0 < 4; ++d0) *(bf16_t*)(st + ((r & 3) + 8 * (r >> 2)) * ST_ROW + d0 * 64) = (bf16_t)cvt_pk_bf16(o[d0][r] * rli[r], 0.f); }
  asm volatile("s_waitcnt lgkmcnt(0)" ::: "memory");
  { const char* sr2 = lds + ST_OFF + wid * (QBLK * ST_ROW) + rw * ST_ROW + ch * 16;
#pragma unroll
    for (int i = 0; i < 8; ++i) { const u32x4 ov = *(const u32x4*)(sr2 + i * 4 * ST_ROW); const u32x4 g = gv[i];
      u32x4 w;
      w.x = cvt_pk_bf16(bf_lo(ov.x) * silu_f(bf_lo(g.x)), bf_hi(ov.x) * silu_f(bf_hi(g.x)));
      w.y = cvt_pk_bf16(bf_lo(ov.y) * silu_f(bf_lo(g.y)), bf_hi(ov.y) * silu_f(bf_hi(g.y)));
      w.z = cvt_pk_bf16(bf_lo(ov.z) * silu_f(bf_lo(g.z)), bf_hi(ov.z) * silu_f(bf_hi(g.z)));
      w.w = cvt_pk_bf16(bf_lo(ov.w) * silu_f(bf_lo(g.w)), bf_hi(ov.w) * silu_f(bf_hi(g.w)));
      *(u32x4*)(Ow + i * 4 * LDO) = w; } }
#undef DMA
#undef BAR
#undef WAITV
#undef RESC
#undef QKT
#undef PIPE1
#undef PVL
#undef PVM
#undef SGB
#undef HALF2
}
}

constexpr size_t MiB = 1u << 20;
constexpr size_t WS_BAR = 0;
constexpr size_t WS_MOD = 1 * MiB;
constexpr size_t WS_ROPE = 2 * MiB;
constexpr size_t WS_WIN = 6 * MiB;
constexpr size_t WS_WAO = 11 * MiB;
constexpr size_t WS_WPIN = 13 * MiB;
constexpr size_t WS_SW = 20 * MiB;
constexpr size_t WS_RSS = 21 * MiB;
constexpr size_t WS_WPO = 18 * MiB;
constexpr size_t WS_H = 32 * MiB;
constexpr size_t WS_Q = 192 * MiB;
constexpr size_t WS_K = 352 * MiB;
constexpr size_t WS_V = 392 * MiB;
constexpr size_t WS_G = 432 * MiB;
constexpr size_t WS_END = 592 * MiB;

constexpr int RING_BYTES = 131072, XCH_OFF = RING_BYTES, LDS_BYTES = 147456, MISC_OFF = LDS_BYTES - 256;

struct Params {
    const float *xp, *xs, *cp, *cs, *norm_g, *ada_w, *ada_b, *attn_w_in, *qg, *kg, *attn_w_out, *pool_w_in, *pool_w_group, *pool_scale, *pool_w_out;
    float* out; unsigned char* ws; int ph_lo, ph_hi;
};

__device__ __forceinline__ float wave_sum(float v) {
#pragma unroll
    for (int o = 1; o < 64; o <<= 1) v += __shfl_xor(v, o);
    return v;
}
__device__ __forceinline__ unsigned f2bf(float f) { unsigned u = __builtin_bit_cast(unsigned, f); return (u + 0x7fffu + ((u >> 16) & 1u)) >> 16; }
__device__ __forceinline__ unsigned pk2(float lo, float hi) { return f2bf(lo) | (f2bf(hi) << 16); }

__device__ __forceinline__ void p0_transpose_item(const float* W, int K, int N, int ldw, bf16_t* WT, int row_off, LAS float* scr, int item, int lane) {
    const int nblk = N / 32, kb = item / nblk, nb = item % nblk, k0 = 64 * kb, n0 = 32 * nb;
#pragma unroll 8
    for (int i = 0; i < 32; ++i) { const int kk = 2 * i + (lane >> 5); scr[kk * 33 + (lane & 31)] = W[(size_t)(k0 + kk) * ldw + n0 + (lane & 31)]; }
    asm volatile("s_waitcnt lgkmcnt(0)" ::: "memory");
    const int c = lane & 7;
#pragma unroll
    for (int j = 0; j < 4; ++j) { const int n = (lane >> 3) + 8 * j; const LAS float* s = scr + (8 * c) * 33 + n;
        u32x4 o; o.x = pk2(s[0 * 33], s[1 * 33]); o.y = pk2(s[2 * 33], s[3 * 33]); o.z = pk2(s[4 * 33], s[5 * 33]); o.w = pk2(s[6 * 33], s[7 * 33]);
        *(u32x4*)(WT + (size_t)(row_off + n0 + n) * K + k0 + 8 * c) = o; }
    asm volatile("s_waitcnt lgkmcnt(0)" ::: "memory");
}

__device__ __forceinline__ void modnorm_phase(const float* xa, const float* xb, const float* g, const float* mod, int layer, bf16_t* H, int gw, int NGW, int lane) {
    const int per = (((M + NGW - 1) / NGW) + 7) & ~7; const int r0 = gw * per; int r1 = r0 + per; if (r1 > M) r1 = M;
    int curb = -1; f32x4 a[4], sh[4];
    for (int m = r0; m < r1; m += 8) {
        const int b = m / SEQ;
        if (b != curb) { curb = b; const float* md = mod + (size_t)(b * 2 + layer) * 3072;
#pragma unroll
            for (int j = 0; j < 4; ++j) { const f32x4 gv = ((const f32x4*)g)[lane + 64 * j], sc = ((const f32x4*)(md + 1024))[lane + 64 * j];
                a[j] = gv * (sc + 1.0f); sh[j] = ((const f32x4*)md)[lane + 64 * j]; } }
        const float* xrow = (m < MP) ? xa + (size_t)m * DM : xb + (size_t)(m - MP) * DM;
        f32x4 v[8][4]; float s[8];
#pragma unroll
        for (int r = 0; r < 8; ++r) { const f32x4* xr = (const f32x4*)(xrow + (size_t)r * DM) + lane;
#pragma unroll
            for (int j = 0; j < 4; ++j) v[r][j] = xr[64 * j]; }
#pragma unroll
        for (int r = 0; r < 8; ++r) { float t = 0.f;
#pragma unroll
            for (int j = 0; j < 4; ++j) t += (v[r][j][0] * v[r][j][0] + v[r][j][1] * v[r][j][1]) + (v[r][j][2] * v[r][j][2] + v[r][j][3] * v[r][j][3]);
            s[r] = t; }
#pragma unroll
        for (int o = 1; o < 64; o <<= 1) {
#pragma unroll
            for (int r = 0; r < 8; ++r) s[r] += __shfl_xor(s[r], o); }
#pragma unroll
        for (int r = 0; r < 8; ++r) { const float rstd = 1.0f / sqrtf(s[r] * (1.0f / DM) + RMS_EPS);
            u32x2* o8 = (u32x2*)(H + (size_t)(m + r) * DM) + lane;
#pragma unroll
            for (int j = 0; j < 4; ++j) { const f32x4 y = v[r][j] * rstd * a[j] + sh[j]; u32x2 w; w.x = cvt_pk_bf16(y[0], y[1]); w.y = cvt_pk_bf16(y[2], y[3]); o8[64 * j] = w; } }
    }
}

constexpr int PR = 16;
#define ACC8(S, OP, V) do { S[0] OP bf_lo(V.x); S[1] OP bf_hi(V.x); S[2] OP bf_lo(V.y); S[3] OP bf_hi(V.y); S[4] OP bf_lo(V.z); S[5] OP bf_hi(V.z); S[6] OP bf_lo(V.w); S[7] OP bf_hi(V.w); } while (0)
__device__ __forceinline__ void pool_gate_phase(const bf16_t* Z, const bf16_t* G2, const float* scale, bf16_t* O, long gtid, long NT) {
    for (long it = gtid; it < (long)(M / PR) * 128; it += NT) {
        const int ch = (int)(it & 127), m0 = (int)(it >> 7) * PR, hw = 1 << (ch >> 5), s0 = m0 & (SEQ - 1);
        const size_t seq0 = (size_t)(m0 - s0) * DM + ch * 8;
        const bf16_t* zb = Z + seq0; const bf16_t* gb = G2 + seq0; bf16_t* ob = O + seq0;
        const f32x4 sc0 = *(const f32x4*)(scale + ch * 8), sc1 = *(const f32x4*)(scale + ch * 8 + 4);
        float sum[8];
#pragma unroll
        for (int i = 0; i < 8; ++i) sum[i] = 0.f;
        { int lo = s0 - hw, hi = s0 + hw; if (lo < 0) lo = 0; if (hi > SEQ) hi = SEQ;
          for (int r = lo; r < hi; ++r) { const u32x4 v = *(const u32x4*)(zb + (size_t)r * DM); ACC8(sum, +=, v); } }
#pragma unroll
        for (int tb = 0; tb < PR; tb += 8) {
            u32x4 c[8], gt[8], ve[8], vl[8]; float me[8], ml[8], inv[8];
#pragma unroll
            for (int k = 0; k < 8; ++k) { const int t = s0 + tb + k;
                c[k] = *(const u32x4*)(zb + (size_t)t * DM); gt[k] = *(const u32x4*)(gb + (size_t)t * DM);
                int lo = t - hw, hi = t + hw; me[k] = hi < SEQ ? 1.f : 0.f; ml[k] = lo >= 0 ? 1.f : 0.f; if (lo < 0) lo = 0; if (hi > SEQ - 1) hi = SEQ - 1;
                ve[k] = *(const u32x4*)(zb + (size_t)hi * DM); vl[k] = *(const u32x4*)(zb + (size_t)lo * DM);
                inv[k] = 1.0f / (float)((t + hw > SEQ ? SEQ : t + hw) - lo); }
#pragma unroll
            for (int k = 0; k < 8; ++k) { const int t = s0 + tb + k; const u32x4 cc = c[k], g = gt[k]; const float iv = inv[k];
                u32x4 w;
                w.x = cvt_pk_bf16((sum[0] * iv - bf_lo(cc.x)) * sc0[0] * silu_f(bf_lo(g.x)), (sum[1] * iv - bf_hi(cc.x)) * sc0[1] * silu_f(bf_hi(g.x)));
                w.y = cvt_pk_bf16((sum[2] * iv - bf_lo(cc.y)) * sc0[2] * silu_f(bf_lo(g.y)), (sum[3] * iv - bf_hi(cc.y)) * sc0[3] * silu_f(bf_hi(g.y)));
                w.z = cvt_pk_bf16((sum[4] * iv - bf_lo(cc.z)) * sc1[0] * silu_f(bf_lo(g.z)), (sum[5] * iv - bf_hi(cc.z)) * sc1[1] * silu_f(bf_hi(g.z)));
                w.w = cvt_pk_bf16((sum[6] * iv - bf_lo(cc.w)) * sc1[2] * silu_f(bf_lo(g.w)), (sum[7] * iv - bf_hi(cc.w)) * sc1[3] * silu_f(bf_hi(g.w)));
                *(u32x4*)(ob + (size_t)t * DM) = w;
                const u32x4 e_ = ve[k], l_ = vl[k]; const float a_ = me[k], b_ = ml[k];
                sum[0] += a_ * bf_lo(e_.x) - b_ * bf_lo(l_.x); sum[1] += a_ * bf_hi(e_.x) - b_ * bf_hi(l_.x); sum[2] += a_ * bf_lo(e_.y) - b_ * bf_lo(l_.y); sum[3] += a_ * bf_hi(e_.y) - b_ * bf_hi(l_.y);
                sum[4] += a_ * bf_lo(e_.z) - b_ * bf_lo(l_.z); sum[5] += a_ * bf_hi(e_.z) - b_ * bf_hi(l_.z); sum[6] += a_ * bf_lo(e_.w) - b_ * bf_lo(l_.w); sum[7] += a_ * bf_hi(e_.w) - b_ * bf_hi(l_.w); }
            asm volatile("" ::: "memory");
        }
    }
}


#define XB_TMO      128
#define XB_XCNT(j)  (256  + 64 * (j))
#define XB_XSUB(j)  (1280 + 64 * (j))
#define XB_XGEN(j)  (2304 + 64 * (j))
#define XB_TOP      3328
#define XB_TOPGEN   3392
#define XCD_BAR_WORDS 3456
#define XB_SPIN_CAP (1u << 18)
__device__ __forceinline__ unsigned xb_ld(unsigned* p)              { return __hip_atomic_load(p, __ATOMIC_RELAXED, __HIP_MEMORY_SCOPE_AGENT); }
__device__ __forceinline__ unsigned xb_add(unsigned* p, unsigned v) { return __hip_atomic_fetch_add(p, v, __ATOMIC_RELAXED, __HIP_MEMORY_SCOPE_AGENT); }
__device__ __forceinline__ unsigned xb_xcc_id() { return (unsigned)__builtin_amdgcn_s_getreg((3 << 11) | 20) & 0xFu; }
#define XB_SPIN(cond, bar) do { unsigned _sp = 0; while (cond) { __builtin_amdgcn_s_sleep(1); \
    if ((++_sp & 255u) == 0u) { if (xb_ld(&(bar)[XB_TMO])) break; if (_sp > XB_SPIN_CAP) { atomicAdd(&(bar)[XB_TMO], 1u); break; } } } } while (0)
__device__ __forceinline__ void xcd_barrier_complete(unsigned* bar, unsigned x, unsigned& nloc, unsigned& nx) {
    const unsigned G = gridDim.x * gridDim.y * gridDim.z;
    unsigned sum, cnt, mine, sp = 0u;
    for (;;) {
        sum = 0u; cnt = 0u; mine = 0u;
#pragma unroll
        for (unsigned j = 0; j < 16; ++j) { const unsigned c = xb_ld(&bar[XB_XCNT(j)]); sum += c; cnt += (c > 0u) ? 1u : 0u; mine = (j == x) ? c : mine; }
        if (sum == G) break;
        __builtin_amdgcn_s_sleep(1);
        if ((++sp & 255u) == 0u) { if (xb_ld(&bar[XB_TMO])) break; if (sp > XB_SPIN_CAP) { atomicAdd(&bar[XB_TMO], 1u); break; } }
    }
    nloc = mine > 0u ? mine : 1u; nx = cnt > 0u ? cnt : 1u;
}
__device__ __forceinline__ void xcd_barrier(unsigned* bar, volatile LAS unsigned* st, const bool leader) {
    asm volatile("s_waitcnt vmcnt(0)" ::: "memory");
    __syncthreads();
    if (leader) {
        const unsigned x = xb_xcc_id();
        __builtin_amdgcn_s_waitcnt(0);
        unsigned nloc = st[0], nx = st[1];
        if (nloc == 0u) { xcd_barrier_complete(bar, x, nloc, nx); st[0] = nloc; st[1] = nx; }
        const unsigned old = xb_add(&bar[XB_XSUB(x)], 1u);
        const unsigned gen = old / nloc;
        if (old + 1u == (gen + 1u) * nloc) {
            __builtin_amdgcn_fence(__ATOMIC_RELEASE, "agent");
            asm volatile("s_waitcnt vmcnt(0)" ::: "memory");
            const unsigned og = xb_add(&bar[XB_TOP], 1u);
            const unsigned tg = og / nx;
            if (og + 1u == (tg + 1u) * nx) xb_add(&bar[XB_TOPGEN], 1u);
            else XB_SPIN(xb_ld(&bar[XB_TOPGEN]) == tg, bar);
            __builtin_amdgcn_fence(__ATOMIC_ACQUIRE, "agent");
            xb_add(&bar[XB_XGEN(x)], 1u);
            asm volatile("s_waitcnt vmcnt(0)" ::: "memory");
        } else {
            XB_SPIN(xb_ld(&bar[XB_XGEN(x)]) == gen, bar);
            __builtin_amdgcn_fence(__ATOMIC_ACQUIRE, "agent");
            asm volatile("s_waitcnt vmcnt(0)" ::: "memory");
        }
    }
    __syncthreads();
}

__global__ void __launch_bounds__(512, 2) fwd_megakernel(Params p) {
    extern __shared__ __attribute__((aligned(16))) unsigned char lds[];
    cg::grid_group grid = cg::this_grid();
    LAS unsigned char* L = (LAS unsigned char*)lds;
    const int wave = __builtin_amdgcn_readfirstlane((int)threadIdx.x >> 6);
#define lane lane_id()
#define tid (wave * 64 + lane_id())
    const int G = gridDim.x, bx = blockIdx.x;
    if (threadIdx.x < 2) ((volatile LAS unsigned*)(L + MISC_OFF))[threadIdx.x] = 0u;
    __syncthreads();
    const int vcu = (G % 8 == 0) ? (bx % 8) * (G / 8) + bx / 8 : bx;
    const int gw = vcu * 8 + wave, NGW = G * 8;
    typedef const __attribute__((address_space(4))) Params* KP;
    const KP kp = (KP)__builtin_amdgcn_kernarg_segment_ptr();
#define PP() KP q = kp; asm volatile("" : "+s"(q)); unsigned char* const ws = q->ws; (void)ws
#define mod ((float*)(ws + WS_MOD))
#define rope ((float*)(ws + WS_ROPE))
#define Win ((bf16_t*)(ws + WS_WIN))
#define Wao ((bf16_t*)(ws + WS_WAO))
#define Wpin ((bf16_t*)(ws + WS_WPIN))
#define SWv ((float*)(ws + WS_SW))
#define RSS ((float*)(ws + WS_RSS))
#define Wpo ((bf16_t*)(ws + WS_WPO))
#define Hb ((bf16_t*)(ws + WS_H))
#define Qb ((bf16_t*)(ws + WS_Q))
#define Kb ((bf16_t*)(ws + WS_K))
#define Vb ((bf16_t*)(ws + WS_V))
#define Gb ((bf16_t*)(ws + WS_G))
    const int lo = kp->ph_lo, hi = kp->ph_hi;
#ifndef PHASE_MASK
#define PHASE_MASK 0xff
#endif
#define IN(k) (((PHASE_MASK >> (k)) & 1) && lo <= (k) && (k) < hi)
#define SEAM(k) do { if (IN(k) && IN((k) + 1)) { unsigned* bar_ = (unsigned*)(kp->ws + WS_BAR); \
        if ((k) == 0) { grid.sync(); if (tid == 0) (void)xb_add(&bar_[XB_XCNT(xb_xcc_id())], 1u); } \
        else xcd_barrier(bar_, (volatile LAS unsigned*)(L + MISC_OFF), tid == 0); } } while (0)

    if (IN(0)) { PP();
        LAS float* scr = (LAS float*)(L + wave * 16384);
        constexpr int I_IN = 16 * (N_IN / 32), I_AO = 16 * 32, I_PIN = 16 * 32, I_PO = 16 * 32, NITEMS = I_IN + I_AO + I_PIN + I_PO;
        for (int it = gw; it < NITEMS; it += NGW) {
            int r = it;
            if (r < I_IN) { p0_transpose_item(q->attn_w_in, DM, N_IN, N_IN, Win, 0, scr, r, lane); continue; } r -= I_IN;
            if (r < I_AO) { p0_transpose_item(q->attn_w_out, DM, DM, DM, Wao, 0, scr, r, lane); continue; } r -= I_AO;
            if (r < I_PIN) { p0_transpose_item(q->pool_w_in + DM, DM, DM, 2 * DM, Wpin, DM, scr, r, lane); continue; } r -= I_PIN;
            p0_transpose_item(q->pool_w_out, DM, DM, DM, Wpo, 0, scr, r, lane);
        }
        for (int e = gw * 64 + lane; e < M; e += NGW * 64) RSS[e] = 0.f;
        if (bx == 0) for (int e = tid; e < XCD_BAR_WORDS; e += 512) ((unsigned*)(ws + WS_BAR))[e] = 0u;
        for (int e = gw * 64 + lane; e < SEQ * 64; e += NGW * 64) {
            const int s = e >> 6, pi = e & 63, fi = pi & 31; const float pos = (float)(pi < 32 ? (s >> 6) : (s & 63));
            const double inv = exp2(-(double)(2 * fi) / 64.0 * 13.287712379549449);
            const double ang = (double)((float)((double)pos * (double)(float)inv));
            const double k = rint(ang * 0.15915494309189535); const float rr = (float)(ang - k * 6.283185307179586);
            float sn, cn; __sincosf(rr, &sn, &cn);
            rope[2 * e] = cn; rope[2 * e + 1] = sn;
        }
        __syncthreads();
        LAS float* sc = (LAS float*)L;
        LAS float* part = (LAS float*)(L + 65536);
        for (int e = tid; e < NB * DM; e += 512) { const int b = e >> 10, k = e & 1023; const float cv = (b < NBP) ? q->cp[b * DM + k] : q->cs[(b - NBP) * DM + k]; sc[e] = cv / (1.0f + expf(-cv)); }
        __syncthreads();
        for (int it = bx; it < 2 * 96; it += G) {
            const int i = it / 96, n0 = (it % 96) * 32, col = lane & 31, kh = lane >> 5;
            const float* wp = q->ada_w + (size_t)i * DM * 3072 + n0 + col;
            float acc[NB];
#pragma unroll
            for (int b = 0; b < NB; ++b) acc[b] = 0.f;
#pragma unroll 4
            for (int kk = 0; kk < 64; ++kk) { const int k = wave * 128 + 2 * kk + kh; const float wv = wp[(size_t)k * 3072];
#pragma unroll
                for (int b = 0; b < NB; ++b) acc[b] += sc[b * DM + k] * wv; }
#pragma unroll
            for (int b = 0; b < NB; ++b) { acc[b] += __shfl_xor(acc[b], 32); if (lane < 32) part[(wave * NB + b) * 32 + col] = acc[b]; }
            __syncthreads();
            if (tid < NB * 32) { const int b = tid >> 5, c2 = tid & 31; float s = q->ada_b[i * 3072 + n0 + c2];
#pragma unroll
                for (int w = 0; w < 8; ++w) s += part[(w * NB + b) * 32 + c2];
                mod[(size_t)(b * 2 + i) * 3072 + n0 + c2] = s; }
            __syncthreads();
        }
        { LAS float* As = (LAS float*)L;
          LAS float* Bs = (LAS float*)(L + 16384);
          const int t_ = tid, d = t_ & 63, kq = t_ >> 6;
          for (int it = bx; it < 256; it += G) {
              const int gi = it >> 6, k0 = ((it >> 2) & 15) * 64, d0 = (it & 3) * 64;
              float acc[8];
#pragma unroll
              for (int i = 0; i < 8; ++i) acc[i] = 0.f;
              for (int c0 = 0; c0 < 256; c0 += 32) {
#pragma unroll
                  for (int j = 0; j < 4; ++j) { const int e = t_ + 512 * j; As[(e >> 5) * 33 + (e & 31)] = q->pool_w_in[(size_t)(k0 + (e >> 5)) * 2048 + gi * 256 + c0 + (e & 31)];
                      Bs[e] = q->pool_w_group[(size_t)gi * 65536 + (size_t)(c0 + (e >> 6)) * 256 + d0 + (e & 63)]; }
                  __syncthreads();
#pragma unroll 8
                  for (int cc = 0; cc < 32; ++cc) { const float bv = Bs[cc * 64 + d];
#pragma unroll
                      for (int i = 0; i < 8; ++i) acc[i] += As[(kq * 8 + i) * 33 + cc] * bv; }
                  __syncthreads();
              }
              u32x4 w; w.x = pk2(acc[0], acc[1]); w.y = pk2(acc[2], acc[3]); w.z = pk2(acc[4], acc[5]); w.w = pk2(acc[6], acc[7]);
              *(u32x4*)(Wpin + (size_t)(gi * 256 + d0 + d) * DM + k0 + kq * 8) = w;
          } }
    }
    SEAM(0);
    if (IN(1)) { PP();
        for (int n = gw; n < 2048; n += NGW) {
            const u32x4 w0 = *(const u32x4*)(Wpin + (size_t)n * DM + lane * 8), w1 = *(const u32x4*)(Wpin + (size_t)n * DM + 512 + lane * 8);
            for (int b = 0; b < NB; ++b) { const float* sh = mod + (size_t)(b * 2 + 1) * 3072;
                const f32x4 a0 = *(const f32x4*)(sh + lane * 8), a1 = *(const f32x4*)(sh + lane * 8 + 4), a2 = *(const f32x4*)(sh + 512 + lane * 8), a3 = *(const f32x4*)(sh + 512 + lane * 8 + 4);
                float t = a0[0] * bf_lo(w0.x) + a0[1] * bf_hi(w0.x) + a0[2] * bf_lo(w0.y) + a0[3] * bf_hi(w0.y) + a1[0] * bf_lo(w0.z) + a1[1] * bf_hi(w0.z) + a1[2] * bf_lo(w0.w) + a1[3] * bf_hi(w0.w)
                        + a2[0] * bf_lo(w1.x) + a2[1] * bf_hi(w1.x) + a2[2] * bf_lo(w1.y) + a2[3] * bf_hi(w1.y) + a3[0] * bf_lo(w1.z) + a3[1] * bf_hi(w1.z) + a3[2] * bf_lo(w1.w) + a3[3] * bf_hi(w1.w);
                t = wave_sum(t); if (lane == 0) SWv[(size_t)b * 2048 + n] = t; }
        }
        modnorm_phase(q->xp, q->xs, q->norm_g, mod, 0, Hb, gw, NGW, lane); }
    SEAM(1);
    if (IN(2)) { PP();
        pg8::Gemm g{Hb, Win, M, N_IN, DM, DM, 0}; pg8::StaticOrder S; S.init(M, N_IN, G, bx);
        pg8::EpiQKVG E{ws + WS_Q, ws + WS_K, ws + WS_V, Gb, q->qg, q->kg, rope, (LAS float*)(L + XCH_OFF)};
        pg8::gemm_phase<pg8::EpiQKVG, pg8::StaticOrder>(L, g, S, E, wave);
    }
    SEAM(2);
    if (IN(3)) { PP();
        constexpr int NU = NB * NH * (SEQ / 256);
#define UNIT(i_, b_, h_, qb_) ((G == 256) ? ((i_) < NU / 256 ? ((b_) = ((bx & 7) * (NU / 256) + (i_)) >> 3, (h_) = ((bx & 7) * (NU / 256) + (i_)) & 7, (qb_) = bx >> 3, true) : false) \
                                        : ((i_) * G + bx < NU ? ((qb_) = ((i_) * G + bx) & 31, (b_) = (((i_) * G + bx) >> 5) >> 3, (h_) = (((i_) * G + bx) >> 5) & 7, true) : false))
        att8::v8i qr[2]; int b = 0, h = 0, qb = 0;
        bool have = UNIT(0, b, h, qb);
        if (have) { const int ln = lane; att8::load_q(qr, ws + WS_Q + ((size_t)b * SEQ + (size_t)qb * 256) * DM + h * HD, wave, ln & 31, ln >> 5); }
        for (int i = 0; have; ++i) {
            int bn = 0, hn = 0, qbn = 0; const bool hn_ok = UNIT(i + 1, bn, hn, qbn);
            const size_t m0 = (size_t)b * SEQ + (size_t)qb * 256, qo = m0 * DM + h * HD, ko = (size_t)b * SEQ * KVD + (h >> 2) * HD;
            const size_t m0n = (size_t)bn * SEQ + (size_t)qbn * 256, qon = m0n * DM + hn * HD, kon = (size_t)bn * SEQ * KVD + (hn >> 2) * HD;
            att8::body(ws + WS_Q + qo, ws + WS_K + ko, ws + WS_V + (size_t)(b * 2 + (h >> 2)) * 128 * 8192, Gb + qo, Hb + qo, SEQ, (char*)lds, wave,
                       qr, i > 0, hn_ok, ws + WS_Q + qon, ws + WS_K + kon, ws + WS_V + (size_t)(bn * 2 + (hn >> 2)) * 128 * 8192);
            b = bn; h = hn; qb = qbn; have = hn_ok;
        }
#undef UNIT
    }
    SEAM(3);
    if (IN(4)) { PP();
        pg8::Gemm g{Hb, Wao, M, DM, DM, DM, 0}; pg8::StaticOrder S; S.init(M, DM, G, bx);
        pg8::EpiX1 E{q->xp, q->xs, q->out, Qb, mod, q->norm_g + DM, RSS};
        pg8::gemm_phase<pg8::EpiX1, pg8::StaticOrder>(L, g, S, E, wave);
    }
    SEAM(4);
    if (IN(5)) { PP();
        pg8::Gemm g{Qb, Wpin, M, 2 * DM, DM, DM, 0}; pg8::StaticOrder S; S.init(M, 2 * DM, G, bx);
        pg8::EpiPoolIn E{Hb, Gb, RSS, SWv};
        pg8::gemm_phase<pg8::EpiPoolIn, pg8::StaticOrder>(L, g, S, E, wave);
    }
    SEAM(5);
    if (IN(6)) { PP(); pool_gate_phase(Hb, Gb, q->pool_scale, Qb, (long)gw * 64 + lane, (long)NGW * 64); }
    SEAM(6);
    if (IN(7)) { PP();
        pg8::Gemm g{Qb, Wpo, M, DM, DM, DM, 0}; pg8::StaticOrder S; S.init(M, DM, G, bx);
        pg8::EpiResGate E{q->out, q->out + (size_t)MP * DM, q->out, mod, 1};
        pg8::gemm_phase<pg8::EpiResGate, pg8::StaticOrder>(L, g, S, E, wave);
    }
#undef IN
#undef SEAM
#undef lane
#undef tid
#undef PP
#undef mod
#undef rope
#undef Win
#undef Wao
#undef Wpin
#undef SWv
#undef RSS
#undef Wpo
#undef Hb
#undef Qb
#undef Kb
#undef Vb
#undef Gb
}

extern "C" void kernel_launch(void* const* d_in, const int* in_sizes, int n_in, void* d_out, int out_size, void* d_ws, size_t ws_size, hipStream_t stream) {
    static int grid = 0;
    if (grid == 0) {
        if (n_in != 15 || in_sizes[0] != MP * DM || in_sizes[1] != (M - MP) * DM || out_size != M * DM || ws_size < WS_END) {
            fprintf(stderr, "kernel_launch: shape mismatch (n_in %d, in0 %d, in1 %d, out %d, ws %zu)\n", n_in, n_in > 0 ? in_sizes[0] : -1, n_in > 1 ? in_sizes[1] : -1, out_size, ws_size); grid = -1; return; }
        int dev = 0, cus = 0, per_cu = 0;
        hipGetDevice(&dev); hipDeviceGetAttribute(&cus, hipDeviceAttributeMultiprocessorCount, dev);
        if (hipFuncSetAttribute((const void*)fwd_megakernel, hipFuncAttributeMaxDynamicSharedMemorySize, LDS_BYTES) != hipSuccess) { fprintf(stderr, "kernel_launch: hipFuncSetAttribute failed\n"); grid = -1; return; }
        if (hipOccupancyMaxActiveBlocksPerMultiprocessor(&per_cu, (const void*)fwd_megakernel, 512, LDS_BYTES) != hipSuccess || per_cu < 1) { fprintf(stderr, "kernel_launch: occupancy query gave %d\n", per_cu); per_cu = 1; }
        (void)hipGetLastError();
        grid = cus * per_cu;
    }
    if (grid < 0) return;
    Params p{};
    p.xp = (const float*)d_in[0]; p.xs = (const float*)d_in[1]; p.cp = (const float*)d_in[2]; p.cs = (const float*)d_in[3]; p.norm_g = (const float*)d_in[4];
    p.ada_w = (const float*)d_in[5]; p.ada_b = (const float*)d_in[6]; p.attn_w_in = (const float*)d_in[7]; p.qg = (const float*)d_in[8]; p.kg = (const float*)d_in[9];
    p.attn_w_out = (const float*)d_in[10]; p.pool_w_in = (const float*)d_in[11]; p.pool_w_group = (const float*)d_in[12]; p.pool_scale = (const float*)d_in[13]; p.pool_w_out = (const float*)d_in[14];
    p.out = (float*)d_out; p.ws = (unsigned char*)d_ws;
#if MK_N_LAUNCHES == 1
    p.ph_lo = 0; p.ph_hi = NPHASE;
    void* args[] = {&p};
    hipError_t e = hipLaunchCooperativeKernel((const void*)fwd_megakernel, dim3(grid), dim3(512), args, LDS_BYTES, stream);
    if (e != hipSuccess) fprintf(stderr, "kernel_launch: cooperative launch failed: %s (grid %d)\n", hipGetErrorString(e), grid);
#else
    for (int k = 0; k < NPHASE; ++k) {
        p.ph_lo = k; p.ph_hi = k + 1;
        hipLaunchKernelGGL(fwd_megakernel, dim3(grid), dim3(512), LDS_BYTES, stream, p);
    }
#endif
}
```

```cpp
#include <hip/hip_runtime.h>
#include <hip/hip_cooperative_groups.h>
#include <cstdio>
#include <cstdint>
namespace cg = cooperative_groups;

#ifndef MK_N_LAUNCHES
#define MK_N_LAUNCHES 1
#endif

constexpr int DM = 1024, SEQ = 8192, NB = 10, NBP = 2, M = NB * SEQ, MP = NBP * SEQ;
constexpr int NH = 8, HD = 128, KVD = 256, N_IN = 2560;
constexpr float RMS_EPS = 1e-6f;
constexpr int NPHASE = 8;
constexpr float QSCALE = 8.0f * 0.088388347648318440f * 1.4426950408889634f;

#define LAS __attribute__((address_space(3)))
typedef unsigned short bf16_t;
typedef short bf16x8 __attribute__((ext_vector_type(8)));
typedef short s16x4 __attribute__((ext_vector_type(4)));
typedef float f32x4 __attribute__((ext_vector_type(4)));
typedef float f32x16 __attribute__((ext_vector_type(16)));
typedef unsigned u32x4 __attribute__((ext_vector_type(4)));
typedef unsigned u32x2 __attribute__((ext_vector_type(2)));

__device__ __forceinline__ unsigned cvt_pk_bf16(float lo, float hi) { unsigned r; asm volatile("v_cvt_pk_bf16_f32 %0, %1, %2" : "=v"(r) : "v"(lo), "v"(hi)); return r; }
__device__ __forceinline__ float bf_lo(unsigned w) { return __uint_as_float(w << 16); }
__device__ __forceinline__ float bf_hi(unsigned w) { return __uint_as_float(w & 0xffff0000u); }
__device__ __forceinline__ int lane_id() { return (int)__builtin_amdgcn_mbcnt_hi(~0u, __builtin_amdgcn_mbcnt_lo(~0u, 0u)); }
__device__ __forceinline__ float sum_fq4(float s) {
    { auto r = __builtin_amdgcn_permlane16_swap(__float_as_uint(s), __float_as_uint(s), false, false); s = __uint_as_float(r[0]) + __uint_as_float(r[1]); }
    { auto r = __builtin_amdgcn_permlane32_swap(__float_as_uint(s), __float_as_uint(s), false, false); s = __uint_as_float(r[0]) + __uint_as_float(r[1]); }
    return s;
}
__device__ __forceinline__ float silu_f(float x) { return x * __builtin_amdgcn_rcpf(1.0f + __builtin_amdgcn_exp2f(-1.4426950408889634f * x)); }

namespace pg8 {
constexpr int BM = 256, BK = 64, HALF = 128, HTB = HALF * BK * 2, STAGE_BYTES = 8 * HTB, NXCD = 8, WGM = 8;

__host__ __device__ __forceinline__ int lds_byte(int r, int c) { const int st = (r >> 4) * 2 + (c >> 5), rr = r & 15, cc = c & 31, ob = rr * 64 + cc * 2; return st * 1024 + (ob ^ (((ob >> 9) & 1) << 5)); }
__host__ __device__ __forceinline__ void stage_rc(int b, int& R, int& C) { const int st = b / 1024, sb = b % 1024, swz = sb ^ (((sb >> 9) & 1) << 5); R = (st >> 1) * 16 + swz / 64; C = (st & 1) * 32 + (swz % 64) / 2; }
__host__ __device__ __forceinline__ int perm32(int rho) { const int n = rho >> 4, i = rho & 15; return 8 * (i >> 2) + 4 * n + (i & 3); }

struct Unit { int pm, pn; };
struct Gemm { const bf16_t* A; const bf16_t* Bt; int M, N, K, lda; size_t apn; };

struct StaticOrder {
    int nM, nN, nwg, G, c;
    __host__ __device__ void init(int M_, int N_, int G_, int c_) { nM = M_ / BM; nN = N_ / BM; nwg = nM * nN; G = G_; c = c_; }
    __host__ __device__ bool next(int i, Unit& u) const {
        const long L = (long)i * G + c; if (L >= nwg) return false;
        int wgid = (int)L; { const int q = nwg / NXCD, r = nwg % NXCD, xcd = wgid % NXCD, off = wgid / NXCD; wgid = (xcd < r ? xcd * (q + 1) : r * (q + 1) + (xcd - r) * q) + off; }
        const int nig = WGM * nN, gid = wgid / nig, fm = gid * WGM, gsz = (nM - fm) < WGM ? (nM - fm) : WGM;
        u.pm = fm + ((wgid % nig) % gsz); u.pn = (wgid % nig) / gsz; return true;
    }
};


struct EpiPoolIn {
    static constexpr bool PERM = true;
    bf16_t* Z; bf16_t* G2; const float* rowss; const float* sw;
    __device__ __forceinline__ void operator()(const f32x4 (&acc)[2][2][4][2], const Unit& u, int wr, int wc, int fr, int fq) const {
        const int row0 = u.pm * BM + wr * 64 + fr, b = (u.pm * BM) / SEQ;
        const float* swp = sw + (size_t)b * 2048 + u.pn * BM + wc * 32 + 8 * fq;
        bf16_t* base = ((u.pn < 4) ? Z : G2) + (u.pn & 3) * BM + wc * 32 + 8 * fq;
        float rs[2][4]; f32x4 s4[2][2];
#pragma unroll
        for (int ai = 0; ai < 2; ++ai)
#pragma unroll
            for (int m = 0; m < 4; ++m) rs[ai][m] = rowss[row0 + ai * HALF + m * 16];
#pragma unroll
        for (int bj = 0; bj < 2; ++bj) { s4[bj][0] = *(const f32x4*)(swp + bj * HALF); s4[bj][1] = *(const f32x4*)(swp + bj * HALF + 4); }
#pragma unroll
        for (int ai = 0; ai < 2; ++ai)
#pragma unroll
            for (int m = 0; m < 4; ++m) { const int row = row0 + ai * HALF + m * 16; const float r_ = __builtin_amdgcn_rsqf(rs[ai][m] * (1.0f / DM) + RMS_EPS);
                bf16_t* rowp = base + (size_t)row * DM;
#pragma unroll
                for (int bj = 0; bj < 2; ++bj) { const f32x4 v0 = acc[ai][bj][m][0] * r_ + s4[bj][0], v1 = acc[ai][bj][m][1] * r_ + s4[bj][1];
                    u32x4 w; w.x = cvt_pk_bf16(v0[0], v0[1]); w.y = cvt_pk_bf16(v0[2], v0[3]); w.z = cvt_pk_bf16(v1[0], v1[1]); w.w = cvt_pk_bf16(v1[2], v1[3]);
                    *(u32x4*)(rowp + bj * HALF) = w; } }
    }
};

struct EpiQKVG {
    static constexpr bool PERM = true;
    unsigned char *Q, *Kb, *V; bf16_t* G; const float* qg; const float* kg; const float* rope; LAS float* X;
    __device__ __forceinline__ void operator()(const f32x4 (&acc)[2][2][4][2], const Unit& u, int wr, int wc, int fr, int fq) const {
        const int hc = wc * 32 + 8 * fq;
        if (u.pn <= 4) {
#pragma unroll
            for (int ai = 0; ai < 2; ++ai)
#pragma unroll
                for (int m = 0; m < 4; ++m)
#pragma unroll
                    for (int bj = 0; bj < 2; ++bj) { const f32x4 a = acc[ai][bj][m][0], b = acc[ai][bj][m][1];
                        float s = (a[0] * a[0] + a[1] * a[1]) + (a[2] * a[2] + a[3] * a[3]) + (b[0] * b[0] + b[1] * b[1]) + (b[2] * b[2] + b[3] * b[3]);
                        s = sum_fq4(s);
                        if (fq == 0) X[((ai * HALF + wr * 64 + m * 16 + fr) * 2 + bj) * 4 + wc] = s; }
            asm volatile("s_waitcnt lgkmcnt(0)" ::: "memory"); __builtin_amdgcn_s_barrier(); asm volatile("" ::: "memory");
            const float* gsrc = (u.pn < 4) ? qg : kg;
            const f32x4 g0 = *(const f32x4*)(gsrc + hc), g1 = *(const f32x4*)(gsrc + hc + 4);
            unsigned char* base; int ldc, colt;
            if (u.pn < 4) { base = Q; ldc = DM; colt = u.pn * BM; } else { base = Kb; ldc = KVD; colt = 0; }
#pragma unroll
            for (int ai = 0; ai < 2; ++ai)
#pragma unroll
                for (int m = 0; m < 4; ++m) { const int lr = ai * HALF + wr * 64 + m * 16 + fr, row = u.pm * BM + lr, spos = row & (SEQ - 1);
                    const f32x4* rp = (const f32x4*)(rope + (size_t)spos * 128 + hc); const f32x4 r0 = rp[0], r1 = rp[1];
#pragma unroll
                    for (int bj = 0; bj < 2; ++bj) { const f32x4 sv = *(const LAS f32x4*)(X + (lr * 2 + bj) * 4);
                        const float rs = __builtin_amdgcn_rsqf(((sv[0] + sv[1]) + (sv[2] + sv[3])) * (1.0f / 128.0f) + RMS_EPS) * (u.pn < 4 ? QSCALE : 1.0f);
                        const f32x4 a = acc[ai][bj][m][0] * rs * g0, b = acc[ai][bj][m][1] * rs * g1;
                        u32x2 w; int t0, t1;
                        t0 = __builtin_amdgcn_cvt_pk_fp8_f32(a[0] * r0[0] - a[1] * r0[1], a[0] * r0[1] + a[1] * r0[0], 0, false);
                        t0 = __builtin_amdgcn_cvt_pk_fp8_f32(a[2] * r0[2] - a[3] * r0[3], a[2] * r0[3] + a[3] * r0[2], t0, true);
                        t1 = __builtin_amdgcn_cvt_pk_fp8_f32(b[0] * r1[0] - b[1] * r1[1], b[0] * r1[1] + b[1] * r1[0], 0, false);
                        t1 = __builtin_amdgcn_cvt_pk_fp8_f32(b[2] * r1[2] - b[3] * r1[3], b[2] * r1[3] + b[3] * r1[2], t1, true);
                        w.x = (unsigned)t0; w.y = (unsigned)t1;
                        *(u32x2*)(base + (size_t)row * ldc + colt + bj * HALF + hc) = w; } }
        } else if (u.pn == 5) {
            const int row0 = u.pm * BM + wr * 64 + fr, b = (u.pm * BM) / SEQ;
#pragma unroll
            for (int ai = 0; ai < 2; ++ai)
#pragma unroll
                for (int m = 0; m < 4; ++m) { const int row = row0 + ai * HALF + m * 16, sp = row & (SEQ - 1);
#pragma unroll
                    for (int bj = 0; bj < 2; ++bj) { const f32x4 v0 = acc[ai][bj][m][0], v1 = acc[ai][bj][m][1];
                        const int kk = sp & 63, kq = kk >> 4, kr = kk & 15, oA = ((kq ^ ((2 * fq) & 3)) << 4) + kr, oB = ((kq ^ ((2 * fq + 1) & 3)) << 4) + kr;
                        unsigned char* vp = V + ((size_t)((b * 2 + bj) * 128 + (sp >> 6)) * 8192 + (size_t)hc * 64);
                        int t0 = __builtin_amdgcn_cvt_pk_fp8_f32(v0[0], v0[1], 0, false); t0 = __builtin_amdgcn_cvt_pk_fp8_f32(v0[2], v0[3], t0, true);
                        int t1 = __builtin_amdgcn_cvt_pk_fp8_f32(v1[0], v1[1], 0, false); t1 = __builtin_amdgcn_cvt_pk_fp8_f32(v1[2], v1[3], t1, true);
                        vp[oA] = (unsigned char)t0; vp[64 + oA] = (unsigned char)(t0 >> 8); vp[128 + oA] = (unsigned char)(t0 >> 16); vp[192 + oA] = (unsigned char)((unsigned)t0 >> 24);
                        vp[256 + oB] = (unsigned char)t1; vp[320 + oB] = (unsigned char)(t1 >> 8); vp[384 + oB] = (unsigned char)(t1 >> 16); vp[448 + oB] = (unsigned char)((unsigned)t1 >> 24); }
                    asm volatile("" ::: "memory"); }
        } else {
            bf16_t* base = G; const int ldc = DM, colt = (u.pn - 6) * BM;
            const int row0 = u.pm * BM + wr * 64 + fr;
#pragma unroll
            for (int ai = 0; ai < 2; ++ai)
#pragma unroll
                for (int m = 0; m < 4; ++m) { bf16_t* rowp = base + (size_t)(row0 + ai * HALF + m * 16) * ldc + colt + hc;
#pragma unroll
                    for (int bj = 0; bj < 2; ++bj) { const f32x4 v0 = acc[ai][bj][m][0], v1 = acc[ai][bj][m][1];
                        u32x4 w; w.x = cvt_pk_bf16(v0[0], v0[1]); w.y = cvt_pk_bf16(v0[2], v0[3]); w.z = cvt_pk_bf16(v1[0], v1[1]); w.w = cvt_pk_bf16(v1[2], v1[3]);
                        *(u32x4*)(rowp + bj * HALF) = w; } }
        }
    }
};

struct EpiResGate {
    static constexpr bool PERM = false;
    const float* xa; const float* xb; float* out; const float* mod; int layer;
    __device__ __forceinline__ void operator()(const f32x4 (&acc)[2][2][4][2], const Unit& u, int wr, int wc, int fr, int fq) const {
        const int row0 = u.pm * BM + wr * 64 + fr, b = (u.pm * BM) / SEQ;
        const int col0 = u.pn * BM + wc * 32 + 4 * fq;
        const float* gt = mod + (size_t)(b * 2 + layer) * 3072 + 2048 + col0;
        f32x4 gv[2][2];
#pragma unroll
        for (int bj = 0; bj < 2; ++bj)
#pragma unroll
            for (int n = 0; n < 2; ++n) gv[bj][n] = *(const f32x4*)(gt + bj * HALF + n * 16);
#pragma unroll
        for (int ai = 0; ai < 2; ++ai) { f32x4 xv[4][2][2];
#pragma unroll
            for (int m = 0; m < 4; ++m) { const int row = row0 + ai * HALF + m * 16;
                const float* xr = (row < MP ? xa + (size_t)row * DM : xb + (size_t)(row - MP) * DM) + col0;
#pragma unroll
                for (int bj = 0; bj < 2; ++bj)
#pragma unroll
                    for (int n = 0; n < 2; ++n) xv[m][bj][n] = __builtin_nontemporal_load((const f32x4*)(xr + bj * HALF + n * 16)); }
#pragma unroll
            for (int m = 0; m < 4; ++m) { float* orow = out + (size_t)(row0 + ai * HALF + m * 16) * DM + col0;
#pragma unroll
                for (int bj = 0; bj < 2; ++bj)
#pragma unroll
                    for (int n = 0; n < 2; ++n) __builtin_nontemporal_store(xv[m][bj][n] + gv[bj][n] * acc[ai][bj][m][n], (f32x4*)(orow + bj * HALF + n * 16)); }
            asm volatile("" ::: "memory"); }
    }
};

struct EpiX1 {
    static constexpr bool PERM = false;
    const float* xa; const float* xb; float* out; bf16_t* X1A; const float* mod; const float* g1; float* rowss;
    __device__ __forceinline__ void operator()(const f32x4 (&acc)[2][2][4][2], const Unit& u, int wr, int wc, int fr, int fq) const {
        const int row0 = u.pm * BM + wr * 64 + fr, b = (u.pm * BM) / SEQ;
        const int col0 = u.pn * BM + wc * 32 + 4 * fq;
        const float* gt = mod + (size_t)(b * 2 + 0) * 3072 + 2048 + col0;
        const float* sc1 = mod + (size_t)(b * 2 + 1) * 3072 + 1024 + col0;
        f32x4 gv[2][2], av[2][2];
#pragma unroll
        for (int bj = 0; bj < 2; ++bj)
#pragma unroll
            for (int n = 0; n < 2; ++n) { gv[bj][n] = *(const f32x4*)(gt + bj * HALF + n * 16);
                av[bj][n] = *(const f32x4*)(g1 + col0 + bj * HALF + n * 16) * (*(const f32x4*)(sc1 + bj * HALF + n * 16) + 1.0f); }
#pragma unroll
        for (int ai = 0; ai < 2; ++ai)
#pragma unroll
            for (int mp = 0; mp < 2; ++mp) { f32x4 xv[2][2][2];
#pragma unroll
                for (int mm = 0; mm < 2; ++mm) { const int row = row0 + ai * HALF + (2 * mp + mm) * 16;
                    const float* xr = (row < MP ? xa + (size_t)row * DM : xb + (size_t)(row - MP) * DM) + col0;
#pragma unroll
                    for (int bj = 0; bj < 2; ++bj)
#pragma unroll
                        for (int n = 0; n < 2; ++n) xv[mm][bj][n] = *(const f32x4*)(xr + bj * HALF + n * 16); }
#pragma unroll
                for (int mm = 0; mm < 2; ++mm) { const int m = 2 * mp + mm, row = row0 + ai * HALF + m * 16;
                    float* orow = out + (size_t)row * DM + col0; bf16_t* arow = X1A + (size_t)row * DM + col0; float ss = 0.f;
#pragma unroll
                    for (int bj = 0; bj < 2; ++bj)
#pragma unroll
                        for (int n = 0; n < 2; ++n) { const f32x4 o = xv[mm][bj][n] + gv[bj][n] * acc[ai][bj][m][n];
                            *(f32x4*)(orow + bj * HALF + n * 16) = o; ss += (o[0] * o[0] + o[1] * o[1]) + (o[2] * o[2] + o[3] * o[3]);
                            const f32x4 y = o * av[bj][n]; u32x2 w; w.x = cvt_pk_bf16(y[0], y[1]); w.y = cvt_pk_bf16(y[2], y[3]); *(u32x2*)(arow + bj * HALF + n * 16) = w; }
                    ss = sum_fq4(ss);
                    if (fq == 0) (void)__hip_atomic_fetch_add(rowss + row, ss, __ATOMIC_RELAXED, __HIP_MEMORY_SCOPE_AGENT); }
                asm volatile("" ::: "memory"); }
    }
};

template <class Epi, class Sched>
__device__ __forceinline__ void gemm_phase(LAS unsigned char* lds, const Gemm g, const Sched& S, const Epi& E, const int wid) {
    const int lane = lane_id(), tid = wid * 64 + lane, wr = wid >> 2, wc = wid & 3, fr = lane & 15, fq = lane >> 4;
    const int K = g.K, nt = K / BK;
    unsigned voffA[2], voffB[2];
#pragma unroll
    for (int i = 0; i < 2; ++i) { int R, C; stage_rc(tid * 16 + i * 8192, R, C); const int Rb = Epi::PERM ? ((R & ~31) + perm32(R & 31)) : R;
        voffA[i] = (unsigned)(R * g.lda + C) * 2u; voffB[i] = (unsigned)(Rb * K + C) * 2u; }
    const size_t kstep = (size_t)(BK * 2);
    const size_t hstepA = (size_t)HALF * g.lda * 2, hstepB = (size_t)HALF * K * 2;
    const size_t tstepA = 2 * hstepA, tstepB = 2 * hstepB;
    const unsigned ldsw = (unsigned)wid * 1024u;
    const int aoff = lds_byte(wr * 64 + fr, fq * 8), boff = lds_byte(wc * 32 + fr, fq * 8);
#define PG8_SA(b, h) (((b) * 2 + (h)) * HTB)
#define PG8_SB(b, h) ((4 + (b) * 2 + (h)) * HTB)
#define PG8_STAGE(bufoff, gbase, voff) do { _Pragma("unroll") for (int _i = 0; _i < 2; ++_i) \
        __builtin_amdgcn_global_load_lds((const unsigned*)((const char*)(gbase) + (voff)[_i]), (LAS unsigned*)(lds + (bufoff) + ldsw + _i * 8192), 16, 0, 0); } while (0)
#define PG8_LDA(dst, b, h) do { _Pragma("unroll") for (int m = 0; m < 4; ++m) _Pragma("unroll") for (int k = 0; k < 2; ++k) dst[m][k] = *(const LAS bf16x8*)(lds + PG8_SA(b, h) + aoff + m * 2048 + k * 1024); } while (0)
#define PG8_LDB(dst, b, h) do { _Pragma("unroll") for (int n = 0; n < 2; ++n) _Pragma("unroll") for (int k = 0; k < 2; ++k) dst[n][k] = *(const LAS bf16x8*)(lds + PG8_SB(b, h) + boff + n * 2048 + k * 1024); } while (0)
#define PG8_MMA(ai, bj, At, Bt) do { __builtin_amdgcn_s_setprio(1); _Pragma("unroll") for (int m = 0; m < 4; ++m) _Pragma("unroll") for (int n = 0; n < 2; ++n) _Pragma("unroll") for (int k = 0; k < 2; ++k) \
        acc[ai][bj][m][n] = __builtin_amdgcn_mfma_f32_16x16x32_bf16(Bt[n][k], At[m][k], acc[ai][bj][m][n], 0, 0, 0); __builtin_amdgcn_s_setprio(0); } while (0)
#define PG8_WAIT_V(n) asm volatile("s_waitcnt vmcnt(" #n ")" ::: "memory")
#define PG8_WAIT_L(n) asm volatile("s_waitcnt lgkmcnt(" #n ")" ::: "memory")
#define PG8_BAR __builtin_amdgcn_s_barrier()
#define PG8_SCHED __builtin_amdgcn_sched_barrier(0)
    Unit cur, nxt; int ui = 0;
    if (!S.next(0, cur)) return;
    f32x4 acc[2][2][4][2];
#pragma unroll
    for (int a = 0; a < 2; ++a)
#pragma unroll
        for (int b = 0; b < 2; ++b)
#pragma unroll
            for (int m = 0; m < 4; ++m)
#pragma unroll
                for (int n = 0; n < 2; ++n) acc[a][b][m][n] = (f32x4){0.f, 0.f, 0.f, 0.f};
    bf16x8 At[4][2], B0[2][2], B1[2][2];
    const char* cA = (const char*)g.A + (size_t)cur.pm * tstepA + (size_t)cur.pn * g.apn; const char* cB = (const char*)g.Bt + (size_t)cur.pn * tstepB;
    PG8_STAGE(PG8_SB(0, 0), cB, voffB); PG8_STAGE(PG8_SB(0, 1), cB + hstepB, voffB); PG8_STAGE(PG8_SA(0, 0), cA, voffA); PG8_STAGE(PG8_SA(0, 1), cA + hstepA, voffA);
    if (wr == 1) PG8_BAR;
    PG8_WAIT_V(2); PG8_BAR;
    PG8_STAGE(PG8_SB(1, 0), cB + kstep, voffB); PG8_STAGE(PG8_SA(1, 0), cA + kstep, voffA); PG8_STAGE(PG8_SB(1, 1), cB + hstepB + kstep, voffB);
    PG8_WAIT_V(6); PG8_BAR;
    for (;;) {
        const bool has_next = S.next(ui + 1, nxt);
        const char* nA = has_next ? (const char*)g.A + (size_t)nxt.pm * tstepA + (size_t)nxt.pn * g.apn : cA; const char* nB = has_next ? (const char*)g.Bt + (size_t)nxt.pn * tstepB : cB;
        for (int t = 0; t < nt; t += 2) {
            const bool last = (t == nt - 2);
            const char* a1 = cA + (size_t)(t + 1) * kstep;
            const char* a2 = last ? nA : cA + (size_t)(t + 2) * kstep; const char* b2 = last ? nB : cB + (size_t)(t + 2) * kstep;
            const char* a3 = a2 + kstep; const char* b3 = b2 + kstep;
            PG8_LDB(B0, 0, 0); PG8_LDB(B1, 0, 1); PG8_SCHED; PG8_LDA(At, 0, 0); PG8_STAGE(PG8_SA(1, 1), a1 + hstepA, voffA);
            PG8_WAIT_V(8); PG8_WAIT_L(0); PG8_BAR; PG8_MMA(0, 0, At, B0); PG8_MMA(0, 1, At, B1); PG8_BAR; PG8_SCHED;
            PG8_LDA(At, 0, 1); PG8_STAGE(PG8_SB(0, 0), b2, voffB); PG8_STAGE(PG8_SB(0, 1), b2 + hstepB, voffB); PG8_STAGE(PG8_SA(0, 0), a2, voffA);
            PG8_WAIT_V(8); PG8_WAIT_L(0); PG8_BAR; PG8_MMA(1, 0, At, B0); PG8_MMA(1, 1, At, B1); PG8_BAR; PG8_SCHED;
            PG8_LDB(B0, 1, 0); PG8_LDB(B1, 1, 1); PG8_SCHED; PG8_LDA(At, 1, 0); PG8_STAGE(PG8_SA(0, 1), a2 + hstepA, voffA);
            PG8_WAIT_V(8); PG8_WAIT_L(0); PG8_BAR; PG8_MMA(0, 0, At, B0); PG8_MMA(0, 1, At, B1); PG8_BAR; PG8_SCHED;
            PG8_LDA(At, 1, 1); PG8_STAGE(PG8_SB(1, 0), b3, voffB); PG8_STAGE(PG8_SB(1, 1), b3 + hstepB, voffB); PG8_STAGE(PG8_SA(1, 0), a3, voffA);
            PG8_WAIT_V(8); PG8_WAIT_L(0); PG8_BAR; PG8_MMA(1, 0, At, B0); PG8_MMA(1, 1, At, B1); PG8_BAR; PG8_SCHED;
        }
        if (wr == 0) PG8_BAR;
        E(acc, cur, wr, wc, fr, fq);
        if (!has_next) break;
#pragma unroll
        for (int a = 0; a < 2; ++a)
#pragma unroll
            for (int b = 0; b < 2; ++b)
#pragma unroll
                for (int m = 0; m < 4; ++m)
#pragma unroll
                    for (int n = 0; n < 2; ++n) acc[a][b][m][n] = (f32x4){0.f, 0.f, 0.f, 0.f};
        cur = nxt; cA = nA; cB = nB; ++ui;
        if (wr == 1) PG8_BAR;
    }
    PG8_WAIT_V(0);
    PG8_BAR;
#undef PG8_SA
#undef PG8_SB
#undef PG8_STAGE
#undef PG8_LDA
#undef PG8_LDB
#undef PG8_MMA
#undef PG8_WAIT_V
#undef PG8_WAIT_L
#undef PG8_BAR
#undef PG8_SCHED
}
}

#define SBAR() __builtin_amdgcn_sched_barrier(0)

namespace att8 {
typedef int v8i __attribute__((ext_vector_type(8)));
constexpr int NW = 8, QBLK = 32, KVBLK = 64;
constexpr float SCALE = 0.088388347648318440f;
constexpr float THR = 2.f;
constexpr float PSHIFT = 5.f;
constexpr float THR2 = THR * 1.4426950408889634f;
constexpr int LDO = DM;
constexpr int SHM_T = 8192, K_OFF = 4 * SHM_T, WS_OFF = 8 * SHM_T, ST_OFF = WS_OFF + NW * 64 * 4, ST_ROW = 272;
static_assert(ST_OFF + NW * QBLK * ST_ROW <= 147456, "attention LDS");
#define SCL1 0x7F7F7F7F
#define MFMA8(A, B, C) __builtin_amdgcn_mfma_scale_f32_32x32x64_f8f6f4(A, B, C, 0, 0, 0, SCL1, 0, SCL1)
#define MFMA8Q(A, B, C) __builtin_amdgcn_mfma_scale_f32_32x32x64_f8f6f4(A, B, C, 0, 0, 0, SCL1, 0, 0x7C7C7C7C)
__device__ __forceinline__ int crow(int r, int hi) { return (r & 3) + 8 * (r >> 2) + 4 * hi; }
__device__ __forceinline__ v8i ld32(const char* p0, const char* p1) { const u32x4 a = *(const u32x4*)p0, b = *(const u32x4*)p1; return (v8i){(int)a.x, (int)a.y, (int)a.z, (int)a.w, (int)b.x, (int)b.y, (int)b.z, (int)b.w}; }

__device__ __forceinline__ float max32(const f32x16& p0, const f32x16& p1) {
  float m = p0[0]; for (int r = 1; r < 16; ++r) m = fmaxf(m, p0[r]); for (int r = 0; r < 16; ++r) m = fmaxf(m, p1[r]);
  { auto rr = __builtin_amdgcn_permlane32_swap(__float_as_uint(m), __float_as_uint(m), false, false);
    m = fmaxf(__uint_as_float(rr[0]), __uint_as_float(rr[1])); }
  return m;
}
__device__ __forceinline__ void adjustSM(f32x16& p0, f32x16& p1, f32x16& nm, float& alpha, const float pmax) {
  alpha = 1.f;
  if (__builtin_expect(__any(pmax > PSHIFT + THR2), 0)) {
    const float delta = (pmax > PSHIFT + THR2) ? (pmax - PSHIFT) : 0.f;
    alpha = __builtin_amdgcn_exp2f(-delta);
    for (int r = 0; r < 16; ++r) { p0[r] -= delta; p1[r] -= delta; nm[r] -= delta; }
  }
}
__device__ __forceinline__ void exp16(f32x16& p0) { for (int r = 0; r < 16; ++r) p0[r] = __builtin_amdgcn_exp2f(p0[r]); }
__device__ __forceinline__ void partialSM_first(f32x16& p0, f32x16& p1, f32x16& nm) {
  const float delta = max32(p0, p1) - PSHIFT;
  for (int r = 0; r < 16; ++r) { p0[r] -= delta; p1[r] -= delta; nm[r] -= delta; }
  for (int r = 0; r < 16; ++r) p0[r] = __builtin_amdgcn_exp2f(p0[r]);
}
__device__ __forceinline__ void finishSM(f32x16& p0, f32x16& p1, v8i& pf) {
  for (int r = 0; r < 16; ++r) p1[r] = __builtin_amdgcn_exp2f(p1[r]);
#pragma unroll
  for (int j = 0; j < 4; ++j) {
    int a = __builtin_amdgcn_cvt_pk_fp8_f32(p0[4 * j], p0[4 * j + 1], 0, false); a = __builtin_amdgcn_cvt_pk_fp8_f32(p0[4 * j + 2], p0[4 * j + 3], a, true);
    int b = __builtin_amdgcn_cvt_pk_fp8_f32(p1[4 * j], p1[4 * j + 1], 0, false); b = __builtin_amdgcn_cvt_pk_fp8_f32(p1[4 * j + 2], p1[4 * j + 3], b, true);
    auto rr = __builtin_amdgcn_permlane32_swap((unsigned)a, (unsigned)b, false, false);
    pf[2 * j] = (int)rr[0]; pf[2 * j + 1] = (int)rr[1]; }
}
__device__ __forceinline__ void qkt(f32x16& p0, f32x16& p1, const f32x16& nm, const char* Ks, const v8i* qr, int ko, int c00, int c01, int c10, int c11) {
  { const v8i a0 = ld32(Ks + ko + c00, Ks + ko + c01), a1 = ld32(Ks + 4096 + ko + c00, Ks + 4096 + ko + c01);
    p0 = MFMA8Q(a0, qr[0], nm); p1 = MFMA8Q(a1, qr[0], nm); }
  { const v8i a0 = ld32(Ks + ko + c10, Ks + ko + c11), a1 = ld32(Ks + 4096 + ko + c10, Ks + 4096 + ko + c11);
    p0 = MFMA8Q(a0, qr[1], p0); p1 = MFMA8Q(a1, qr[1], p1); }
}
__device__ __forceinline__ void pv_load(v8i* vf, const char* Vs, int vo, int e0, int e1) {
#pragma unroll
  for (int d0 = 0; d0 < 4; ++d0) vf[d0] = ld32(Vs + d0 * 2048 + vo + e0, Vs + d0 * 2048 + vo + e1);
}
__device__ __forceinline__ void pv_mma(f32x16* o, f32x16& ls, const v8i* vf, const v8i pf) {
#pragma unroll
  for (int d0 = 0; d0 < 4; ++d0) o[d0] = MFMA8(pf, vf[d0], o[d0]);
  const v8i ones = {0x38383838, 0x38383838, 0x38383838, 0x38383838, 0x38383838, 0x38383838, 0x38383838, 0x38383838};
  ls = MFMA8(pf, ones, ls);
}

__device__ __forceinline__ void load_q(v8i (&qr)[2], const unsigned char* Q8b, int wid, int r32, int hi) {
  const char* Qw = (const char*)Q8b + (wid * QBLK + r32) * 1024 + hi * 32;
#pragma unroll
  for (int c = 0; c < 2; ++c) { const u32x4 a = *(const u32x4*)(Qw + c * 64), b = *(const u32x4*)(Qw + c * 64 + 16); qr[c] = (v8i){(int)a.x, (int)a.y, (int)a.z, (int)a.w, (int)b.x, (int)b.y, (int)b.z, (int)b.w}; }
}
__device__ __forceinline__ void body(const unsigned char* Q8b, const unsigned char* K8h, const unsigned char* VT8h, const bf16_t* Gb, bf16_t* Ob, int seq, char* lds, const int wid,
                                     v8i (&qr)[2], const int pre, const int nxt, const unsigned char* Q8n, const unsigned char* K8n, const unsigned char* VT8n) {
  const int lane = lane_id(), tid = wid * 64 + lane, r32 = lane & 31, hi = lane >> 5;
  char* V_lds = lds; char* K_lds = lds + K_OFF;
  float* ws = (float*)(lds + WS_OFF) + wid * 64; float* al_l = ws + 32;
  f32x16 o[4] = {}; f32x16 ls = {}; f32x16 nm;
#pragma unroll
  for (int r = 0; r < 16; ++r) nm[r] = PSHIFT;
  LAS char* L3 = (LAS char*)lds;
  const int krow = wid * 8 + (lane >> 3), kc = (lane & 7) ^ ((krow >> 1) & 7);
  const char* Kg = (const char*)K8h + krow * 256 + kc * 16; const char* Vg = (const char*)VT8h + wid * 1024 + lane * 16;
  const int ksw = (r32 >> 1) & 7, ko = r32 * 128, c00 = ((0 + hi * 2) ^ ksw) << 4, c01 = ((1 + hi * 2) ^ ksw) << 4, c10 = ((4 + hi * 2) ^ ksw) << 4, c11 = ((5 + hi * 2) ^ ksw) << 4;
  const int vsw = (r32 >> 2) & 3, vo = r32 * 64, e0 = ((2 * hi) ^ vsw) << 4, e1 = ((2 * hi + 1) ^ vsw) << 4;
#define DMA(slot, t) do { \
    __builtin_amdgcn_global_load_lds((const unsigned*)(Kg + (long)(t) * (64 * 256)), (LAS unsigned*)(L3 + K_OFF + (slot) * SHM_T + wid * 1024), 16, 0, 0); \
    __builtin_amdgcn_global_load_lds((const unsigned*)(Vg + (long)(t) * 8192), (LAS unsigned*)(L3 + (slot) * SHM_T + wid * 1024), 16, 0, 0); } while (0)
#define BAR() do { asm volatile("s_waitcnt lgkmcnt(0)" ::: "memory"); __builtin_amdgcn_s_barrier(); asm volatile("" ::: "memory"); } while (0)
#define WAITV(n) asm volatile("s_waitcnt vmcnt(" #n ")" ::: "memory")
#define RESC(a) do { if (__any((a) < 1.f)) { if (hi == 0) al_l[r32] = (a); asm volatile("s_waitcnt lgkmcnt(0)" ::: "memory"); \
    for (int r = 0; r < 16; ++r) { const float a_ = al_l[crow(r, hi)]; ls[r] *= a_; for (int d = 0; d < 4; ++d) o[d][r] *= a_; } } } while (0)
#define QKT(P0, P1, b) qkt(P0, P1, nm, K_lds + (b) * SHM_T, qr, ko, c00, c01, c10, c11)
#define SGB(mask, n) __builtin_amdgcn_sched_group_barrier(mask, n, 0)
#define PVL(b) pv_load(vf, V_lds + (b) * SHM_T, vo, e0, e1)
#define PVM() pv_mma(o, ls, vf, pf)
#define PIPE1() do { SGB(0x100, 8); SGB(0x400, 4); SGB(0x008, 1); SGB(0x400, 4); SGB(0x008, 1); SGB(0x400, 4); SGB(0x008, 1); SGB(0x400, 4); SGB(0x008, 1); } while (0)
#define HALF2(Y0, Y1, alY, b) do { PVL(b); const float pm_ = max32(Y0, Y1); adjustSM(Y0, Y1, nm, alY, pm_); SBAR(); \
    PVM(); exp16(Y0); asm volatile("" : "+v"(Y0)); \
    SGB(0x008, 1); SGB(0x400, 3); SGB(0x008, 1); SGB(0x400, 3); SGB(0x008, 1); SGB(0x400, 3); SGB(0x008, 1); SGB(0x400, 3); SGB(0x008, 1); SGB(0x400, 4); SBAR(); } while (0)
  f32x16 pA0, pA1, pB0, pB1; float alA, alB; v8i pf; v8i vf[4]; const int NT = seq / KVBLK;
  if (!pre) { DMA(0, 0); DMA(1, 1); } else BAR();
  DMA(2, 2);
  WAITV(2); BAR();
  QKT(pA0, pA1, 0); partialSM_first(pA0, pA1, nm);
  int s0 = 0;
  for (int i = 0; i + 2 < NT; i += 2) {
    SBAR(); QKT(pB0, pB1, (s0 + 1) & 3);
    finishSM(pA0, pA1, pf); PIPE1(); SBAR();
    DMA((s0 + 3) & 3, i + 3);
    SBAR();
    HALF2(pB0, pB1, alB, s0);
    WAITV(2);
    RESC(alB); BAR();
    SBAR(); QKT(pA0, pA1, (s0 + 2) & 3);
    finishSM(pB0, pB1, pf); PIPE1(); SBAR();
    { const int t4 = (i + 4 < NT) ? i + 4 : NT - 1; DMA(s0, t4); }
    SBAR();
    HALF2(pA0, pA1, alA, (s0 + 1) & 3);
    WAITV(2);
    RESC(alA); BAR();
    s0 = (s0 + 2) & 3;
  }
  SBAR(); QKT(pB0, pB1, (s0 + 1) & 3);
  finishSM(pA0, pA1, pf); SBAR();
  HALF2(pB0, pB1, alB, s0);
  RESC(alB);
  PVL((s0 + 1) & 3); finishSM(pB0, pB1, pf); SBAR();
  PVM();
  WAITV(0);
  if (nxt) {
    load_q(qr, Q8n, wid, r32, hi);
    const char* KgN = (const char*)K8n + krow * 256 + kc * 16; const char* VgN = (const char*)VT8n + wid * 1024 + lane * 16;
#pragma unroll
    for (int tn = 0; tn < 2; ++tn) {
      __builtin_amdgcn_global_load_lds((const unsigned*)(KgN + (long)tn * (64 * 256)), (LAS unsigned*)(L3 + K_OFF + tn * SHM_T + wid * 1024), 16, 0, 0);
      __builtin_amdgcn_global_load_lds((const unsigned*)(VgN + (long)tn * 8192), (LAS unsigned*)(L3 + tn * SHM_T + wid * 1024), 16, 0, 0); }
  }
  float rli[16];
#pragma unroll
  for (int r = 0; r < 16; ++r) rli[r] = __builtin_amdgcn_rcpf(ls[r]);
  const int rw = lane >> 4, ch = lane & 15;
  const bf16_t* Gw = Gb + (wid * QBLK + rw) * LDO + ch * 8; bf16_t* Ow = Ob + (wid * QBLK + rw) * LDO + ch * 8;
  u32x4 gv[8];
#pragma unroll
  for (int i = 0; i < 8; ++i) gv[i] = *(const u32x4*)(Gw + i * 4 * LDO);
  char* st = lds + ST_OFF + wid * (QBLK * ST_ROW) + r32 * 2 + hi * 4 * ST_ROW;
#pragma unroll
  for (int r = 0; r < 16; ++r) {
#pragma unroll
    for (int d0 = 0; d0 < 4; ++d0) *(bf16_t*)(st + ((r & 3) + 8 * (r >> 2)) * ST_ROW + d0 * 64) = (bf16_t)cvt_pk_bf16(o[d0][r] * rli[r], 0.f); }
  asm volatile("s_waitcnt lgkmcnt(0)" ::: "memory");
  { const char* sr2 = lds + ST_OFF + wid * (QBLK * ST_ROW) + rw * ST_ROW + ch * 16;
#pragma unroll
    for (int i = 0; i < 8; ++i) { const u32x4 ov = *(const u32x4*)(sr2 + i * 4 * ST_ROW); const u32x4 g = gv[i];
      u32x4 w;
      w.x = cvt_pk_bf16(bf_lo(ov.x) * silu_f(bf_lo(g.x)), bf_hi(ov.x) * silu_f(bf_hi(g.x)));
      w.y = cvt_pk_bf16(bf_lo(ov.y) * silu_f(bf_lo(g.y)), bf_hi(ov.y) * silu_f(bf_hi(g.y)));
      w.z = cvt_pk_bf16(bf_lo(ov.z) * silu_f(bf_lo(g.z)), bf_hi(ov.z) * silu_f(bf_hi(g.z)));
      w.w = cvt_pk_bf16(bf_lo(ov.w) * silu_f(bf_lo(g.w)), bf_hi(ov.w) * silu_f(bf_hi(g.w)));
      *(u32x4*)(Ow + i * 4 * LDO) = w; } }
#undef DMA
#undef BAR
#undef WAITV
#undef RESC
#undef QKT
#undef PIPE1
#undef PVL
#undef PVM
#undef SGB
#undef HALF2
}
}

constexpr size_t MiB = 1u << 20;
constexpr size_t WS_BAR = 0;
constexpr size_t WS_MOD = 1 * MiB;
constexpr size_t WS_ROPE = 2 * MiB;
constexpr size_t WS_WIN = 6 * MiB;
constexpr size_t WS_WAO = 11 * MiB;
constexpr size_t WS_WPIN = 13 * MiB;
constexpr size_t WS_SW = 20 * MiB;
constexpr size_t WS_RSS = 21 * MiB;
constexpr size_t WS_WPO = 18 * MiB;
constexpr size_t WS_H = 32 * MiB;
constexpr size_t WS_Q = 192 * MiB;
constexpr size_t WS_K = 352 * MiB;
constexpr size_t WS_V = 392 * MiB;
constexpr size_t WS_G = 432 * MiB;
constexpr size_t WS_END = 592 * MiB;

constexpr int RING_BYTES = 131072, XCH_OFF = RING_BYTES, LDS_BYTES = 147456, MISC_OFF = LDS_BYTES - 256;

struct Params {
    const float *xp, *xs, *cp, *cs, *norm_g, *ada_w, *ada_b, *attn_w_in, *qg, *kg, *attn_w_out, *pool_w_in, *pool_w_group, *pool_scale, *pool_w_out;
    float* out; unsigned char* ws; int ph_lo, ph_hi;
};

__device__ __forceinline__ float wave_sum(float v) {
#pragma unroll
    for (int o = 1; o < 64; o <<= 1) v += __shfl_xor(v, o);
    return v;
}
__device__ __forceinline__ unsigned f2bf(float f) { unsigned u = __builtin_bit_cast(unsigned, f); return (u + 0x7fffu + ((u >> 16) & 1u)) >> 16; }
__device__ __forceinline__ unsigned pk2(float lo, float hi) { return f2bf(lo) | (f2bf(hi) << 16); }

__device__ __forceinline__ void p0_transpose_item(const float* W, int K, int N, int ldw, bf16_t* WT, int row_off, LAS float* scr, int item, int lane) {
    const int nblk = N / 32, kb = item / nblk, nb = item % nblk, k0 = 64 * kb, n0 = 32 * nb;
#pragma unroll 8
    for (int i = 0; i < 32; ++i) { const int kk = 2 * i + (lane >> 5); scr[kk * 33 + (lane & 31)] = W[(size_t)(k0 + kk) * ldw + n0 + (lane & 31)]; }
    asm volatile("s_waitcnt lgkmcnt(0)" ::: "memory");
    const int c = lane & 7;
#pragma unroll
    for (int j = 0; j < 4; ++j) { const int n = (lane >> 3) + 8 * j; const LAS float* s = scr + (8 * c) * 33 + n;
        u32x4 o; o.x = pk2(s[0 * 33], s[1 * 33]); o.y = pk2(s[2 * 33], s[3 * 33]); o.z = pk2(s[4 * 33], s[5 * 33]); o.w = pk2(s[6 * 33], s[7 * 33]);
        *(u32x4*)(WT + (size_t)(row_off + n0 + n) * K + k0 + 8 * c) = o; }
    asm volatile("s_waitcnt lgkmcnt(0)" ::: "memory");
}

__device__ __forceinline__ void modnorm_phase(const float* xa, const float* xb, const float* g, const float* mod, int layer, bf16_t* H, int gw, int NGW, int lane) {
    const int per = (((M + NGW - 1) / NGW) + 7) & ~7; const int r0 = gw * per; int r1 = r0 + per; if (r1 > M) r1 = M;
    int curb = -1; f32x4 a[4], sh[4];
    for (int m = r0; m < r1; m += 8) {
        const int b = m / SEQ;
        if (b != curb) { curb = b; const float* md = mod + (size_t)(b * 2 + layer) * 3072;
#pragma unroll
            for (int j = 0; j < 4; ++j) { const f32x4 gv = ((const f32x4*)g)[lane + 64 * j], sc = ((const f32x4*)(md + 1024))[lane + 64 * j];
                a[j] = gv * (sc + 1.0f); sh[j] = ((const f32x4*)md)[lane + 64 * j]; } }
        const float* xrow = (m < MP) ? xa + (size_t)m * DM : xb + (size_t)(m - MP) * DM;
        f32x4 v[8][4]; float s[8];
#pragma unroll
        for (int r = 0; r < 8; ++r) { const f32x4* xr = (const f32x4*)(xrow + (size_t)r * DM) + lane;
#pragma unroll
            for (int j = 0; j < 4; ++j) v[r][j] = __builtin_nontemporal_load(xr + 64 * j); }
#pragma unroll
        for (int r = 0; r < 8; ++r) { float t = 0.f;
#pragma unroll
            for (int j = 0; j < 4; ++j) t += (v[r][j][0] * v[r][j][0] + v[r][j][1] * v[r][j][1]) + (v[r][j][2] * v[r][j][2] + v[r][j][3] * v[r][j][3]);
            s[r] = t; }
#pragma unroll
        for (int o = 1; o < 64; o <<= 1) {
#pragma unroll
            for (int r = 0; r < 8; ++r) s[r] += __shfl_xor(s[r], o); }
#pragma unroll
        for (int r = 0; r < 8; ++r) { const float rstd = 1.0f / sqrtf(s[r] * (1.0f / DM) + RMS_EPS);
            u32x2* o8 = (u32x2*)(H + (size_t)(m + r) * DM) + lane;
#pragma unroll
            for (int j = 0; j < 4; ++j) { const f32x4 y = v[r][j] * rstd * a[j] + sh[j]; u32x2 w; w.x = cvt_pk_bf16(y[0], y[1]); w.y = cvt_pk_bf16(y[2], y[3]); o8[64 * j] = w; } }
    }
}

constexpr int PR = 16;
#define ACC8(S, OP, V) do { S[0] OP bf_lo(V.x); S[1] OP bf_hi(V.x); S[2] OP bf_lo(V.y); S[3] OP bf_hi(V.y); S[4] OP bf_lo(V.z); S[5] OP bf_hi(V.z); S[6] OP bf_lo(V.w); S[7] OP bf_hi(V.w); } while (0)
__device__ __forceinline__ void pool_gate_phase(const bf16_t* Z, const bf16_t* G2, const float* scale, bf16_t* O, long gtid, long NT) {
    for (long it = gtid; it < (long)(M / PR) * 128; it += NT) {
        const int ch = (int)(it & 127), m0 = (int)(it >> 7) * PR, hw = 1 << (ch >> 5), s0 = m0 & (SEQ - 1);
        const size_t seq0 = (size_t)(m0 - s0) * DM + ch * 8;
        const bf16_t* zb = Z + seq0; const bf16_t* gb = G2 + seq0; bf16_t* ob = O + seq0;
        const f32x4 sc0 = *(const f32x4*)(scale + ch * 8), sc1 = *(const f32x4*)(scale + ch * 8 + 4);
        float sum[8];
#pragma unroll
        for (int i = 0; i < 8; ++i) sum[i] = 0.f;
        { int lo = s0 - hw, hi = s0 + hw; if (lo < 0) lo = 0; if (hi > SEQ) hi = SEQ;
          for (int r = lo; r < hi; ++r) { const u32x4 v = *(const u32x4*)(zb + (size_t)r * DM); ACC8(sum, +=, v); } }
#pragma unroll
        for (int tb = 0; tb < PR; tb += 8) {
            u32x4 c[8], gt[8], ve[8], vl[8]; float me[8], ml[8], inv[8];
#pragma unroll
            for (int k = 0; k < 8; ++k) { const int t = s0 + tb + k;
                c[k] = *(const u32x4*)(zb + (size_t)t * DM); gt[k] = *(const u32x4*)(gb + (size_t)t * DM);
                int lo = t - hw, hi = t + hw; me[k] = hi < SEQ ? 1.f : 0.f; ml[k] = lo >= 0 ? 1.f : 0.f; if (lo < 0) lo = 0; if (hi > SEQ - 1) hi = SEQ - 1;
                ve[k] = *(const u32x4*)(zb + (size_t)hi * DM); vl[k] = *(const u32x4*)(zb + (size_t)lo * DM);
                inv[k] = 1.0f / (float)((t + hw > SEQ ? SEQ : t + hw) - lo); }
#pragma unroll
            for (int k = 0; k < 8; ++k) { const int t = s0 + tb + k; const u32x4 cc = c[k], g = gt[k]; const float iv = inv[k];
                u32x4 w;
                w.x = cvt_pk_bf16((sum[0] * iv - bf_lo(cc.x)) * sc0[0] * silu_f(bf_lo(g.x)), (sum[1] * iv - bf_hi(cc.x)) * sc0[1] * silu_f(bf_hi(g.x)));
                w.y = cvt_pk_bf16((sum[2] * iv - bf_lo(cc.y)) * sc0[2] * silu_f(bf_lo(g.y)), (sum[3] * iv - bf_hi(cc.y)) * sc0[3] * silu_f(bf_hi(g.y)));
                w.z = cvt_pk_bf16((sum[4] * iv - bf_lo(cc.z)) * sc1[0] * silu_f(bf_lo(g.z)), (sum[5] * iv - bf_hi(cc.z)) * sc1[1] * silu_f(bf_hi(g.z)));
                w.w = cvt_pk_bf16((sum[6] * iv - bf_lo(cc.w)) * sc1[2] * silu_f(bf_lo(g.w)), (sum[7] * iv - bf_hi(cc.w)) * sc1[3] * silu_f(bf_hi(g.w)));
                *(u32x4*)(ob + (size_t)t * DM) = w;
                const u32x4 e_ = ve[k], l_ = vl[k]; const float a_ = me[k], b_ = ml[k];
                sum[0] += a_ * bf_lo(e_.x) - b_ * bf_lo(l_.x); sum[1] += a_ * bf_hi(e_.x) - b_ * bf_hi(l_.x); sum[2] += a_ * bf_lo(e_.y) - b_ * bf_lo(l_.y); sum[3] += a_ * bf_hi(e_.y) - b_ * bf_hi(l_.y);
                sum[4] += a_ * bf_lo(e_.z) - b_ * bf_lo(l_.z); sum[5] += a_ * bf_hi(e_.z) - b_ * bf_hi(l_.z); sum[6] += a_ * bf_lo(e_.w) - b_ * bf_lo(l_.w); sum[7] += a_ * bf_hi(e_.w) - b_ * bf_hi(l_.w); }
            asm volatile("" ::: "memory");
        }
    }
}


#define XB_TMO      128
#define XB_XCNT(j)  (256  + 64 * (j))
#define XB_XSUB(j)  (1280 + 64 * (j))
#define XB_XGEN(j)  (2304 + 64 * (j))
#define XB_TOP      3328
#define XB_TOPGEN   3392
#define XCD_BAR_WORDS 3456
#define XB_SPIN_CAP (1u << 18)
__device__ __forceinline__ unsigned xb_ld(unsigned* p)              { return __hip_atomic_load(p, __ATOMIC_RELAXED, __HIP_MEMORY_SCOPE_AGENT); }
__device__ __forceinline__ unsigned xb_add(unsigned* p, unsigned v) { return __hip_atomic_fetch_add(p, v, __ATOMIC_RELAXED, __HIP_MEMORY_SCOPE_AGENT); }
__device__ __forceinline__ unsigned xb_xcc_id() { return (unsigned)__builtin_amdgcn_s_getreg((3 << 11) | 20) & 0xFu; }
#define XB_SPIN(cond, bar) do { unsigned _sp = 0; while (cond) { __builtin_amdgcn_s_sleep(1); \
    if ((++_sp & 255u) == 0u) { if (xb_ld(&(bar)[XB_TMO])) break; if (_sp > XB_SPIN_CAP) { atomicAdd(&(bar)[XB_TMO], 1u); break; } } } } while (0)
__device__ __forceinline__ void xcd_barrier_complete(unsigned* bar, unsigned x, unsigned& nloc, unsigned& nx) {
    const unsigned G = gridDim.x * gridDim.y * gridDim.z;
    unsigned sum, cnt, mine, sp = 0u;
    for (;;) {
        sum = 0u; cnt = 0u; mine = 0u;
#pragma unroll
        for (unsigned j = 0; j < 16; ++j) { const unsigned c = xb_ld(&bar[XB_XCNT(j)]); sum += c; cnt += (c > 0u) ? 1u : 0u; mine = (j == x) ? c : mine; }
        if (sum == G) break;
        __builtin_amdgcn_s_sleep(1);
        if ((++sp & 255u) == 0u) { if (xb_ld(&bar[XB_TMO])) break; if (sp > XB_SPIN_CAP) { atomicAdd(&bar[XB_TMO], 1u); break; } }
    }
    nloc = mine > 0u ? mine : 1u; nx = cnt > 0u ? cnt : 1u;
}
__device__ __forceinline__ void xcd_barrier(unsigned* bar, volatile LAS unsigned* st, const bool leader) {
    asm volatile("s_waitcnt vmcnt(0)" ::: "memory");
    __syncthreads();
    if (leader) {
        const unsigned x = xb_xcc_id();
        __builtin_amdgcn_s_waitcnt(0);
        unsigned nloc = st[0], nx = st[1];
        if (nloc == 0u) { xcd_barrier_complete(bar, x, nloc, nx); st[0] = nloc; st[1] = nx; }
        const unsigned old = xb_add(&bar[XB_XSUB(x)], 1u);
        const unsigned gen = old / nloc;
        if (old + 1u == (gen + 1u) * nloc) {
            __builtin_amdgcn_fence(__ATOMIC_RELEASE, "agent");
            asm volatile("s_waitcnt vmcnt(0)" ::: "memory");
            const unsigned og = xb_add(&bar[XB_TOP], 1u);
            const unsigned tg = og / nx;
            if (og + 1u == (tg + 1u) * nx) xb_add(&bar[XB_TOPGEN], 1u);
            else XB_SPIN(xb_ld(&bar[XB_TOPGEN]) == tg, bar);
            __builtin_amdgcn_fence(__ATOMIC_ACQUIRE, "agent");
            xb_add(&bar[XB_XGEN(x)], 1u);
            asm volatile("s_waitcnt vmcnt(0)" ::: "memory");
        } else {
            XB_SPIN(xb_ld(&bar[XB_XGEN(x)]) == gen, bar);
            __builtin_amdgcn_fence(__ATOMIC_ACQUIRE, "agent");
            asm volatile("s_waitcnt vmcnt(0)" ::: "memory");
        }
    }
    __syncthreads();
}

__global__ void __launch_bounds__(512, 2) fwd_megakernel(Params p) {
    extern __shared__ __attribute__((aligned(16))) unsigned char lds[];
    cg::grid_group grid = cg::this_grid();
    LAS unsigned char* L = (LAS unsigned char*)lds;
    const int wave = __builtin_amdgcn_readfirstlane((int)threadIdx.x >> 6);
#define lane lane_id()
#define tid (wave * 64 + lane_id())
    const int G = gridDim.x, bx = blockIdx.x;
    if (threadIdx.x < 2) ((volatile LAS unsigned*)(L + MISC_OFF))[threadIdx.x] = 0u;
    __syncthreads();
    const int vcu = (G % 8 == 0) ? (bx % 8) * (G / 8) + bx / 8 : bx;
    const int gw = vcu * 8 + wave, NGW = G * 8;
    typedef const __attribute__((address_space(4))) Params* KP;
    const KP kp = (KP)__builtin_amdgcn_kernarg_segment_ptr();
#define PP() KP q = kp; asm volatile("" : "+s"(q)); unsigned char* const ws = q->ws; (void)ws
#define mod ((float*)(ws + WS_MOD))
#define rope ((float*)(ws + WS_ROPE))
#define Win ((bf16_t*)(ws + WS_WIN))
#define Wao ((bf16_t*)(ws + WS_WAO))
#define Wpin ((bf16_t*)(ws + WS_WPIN))
#define SWv ((float*)(ws + WS_SW))
#define RSS ((float*)(ws + WS_RSS))
#define Wpo ((bf16_t*)(ws + WS_WPO))
#define Hb ((bf16_t*)(ws + WS_H))
#define Qb ((bf16_t*)(ws + WS_Q))
#define Kb ((bf16_t*)(ws + WS_K))
#define Vb ((bf16_t*)(ws + WS_V))
#define Gb ((bf16_t*)(ws + WS_G))
    const int lo = kp->ph_lo, hi = kp->ph_hi;
#ifndef PHASE_MASK
#define PHASE_MASK 0xff
#endif
#define IN(k) (((PHASE_MASK >> (k)) & 1) && lo <= (k) && (k) < hi)
#define SEAM(k) do { if (IN(k) && IN((k) + 1)) { unsigned* bar_ = (unsigned*)(kp->ws + WS_BAR); \
        if ((k) == 0) { grid.sync(); if (tid == 0) (void)xb_add(&bar_[XB_XCNT(xb_xcc_id())], 1u); } \
        else xcd_barrier(bar_, (volatile LAS unsigned*)(L + MISC_OFF), tid == 0); } } while (0)

    if (IN(0)) { PP();
        LAS float* scr = (LAS float*)(L + wave * 16384);
        constexpr int I_IN = 16 * (N_IN / 32), I_AO = 16 * 32, I_PIN = 16 * 32, I_PO = 16 * 32, NITEMS = I_IN + I_AO + I_PIN + I_PO;
        for (int it = gw; it < NITEMS; it += NGW) {
            int r = it;
            if (r < I_IN) { p0_transpose_item(q->attn_w_in, DM, N_IN, N_IN, Win, 0, scr, r, lane); continue; } r -= I_IN;
            if (r < I_AO) { p0_transpose_item(q->attn_w_out, DM, DM, DM, Wao, 0, scr, r, lane); continue; } r -= I_AO;
            if (r < I_PIN) { p0_transpose_item(q->pool_w_in + DM, DM, DM, 2 * DM, Wpin, DM, scr, r, lane); continue; } r -= I_PIN;
            p0_transpose_item(q->pool_w_out, DM, DM, DM, Wpo, 0, scr, r, lane);
        }
        for (int e = gw * 64 + lane; e < M; e += NGW * 64) RSS[e] = 0.f;
        if (bx == 0) for (int e = tid; e < XCD_BAR_WORDS; e += 512) ((unsigned*)(ws + WS_BAR))[e] = 0u;
        for (int e = gw * 64 + lane; e < SEQ * 64; e += NGW * 64) {
            const int s = e >> 6, pi = e & 63, fi = pi & 31; const float pos = (float)(pi < 32 ? (s >> 6) : (s & 63));
            const double inv = exp2(-(double)(2 * fi) / 64.0 * 13.287712379549449);
            const double ang = (double)((float)((double)pos * (double)(float)inv));
            const double k = rint(ang * 0.15915494309189535); const float rr = (float)(ang - k * 6.283185307179586);
            float sn, cn; __sincosf(rr, &sn, &cn);
            rope[2 * e] = cn; rope[2 * e + 1] = sn;
        }
        __syncthreads();
        LAS float* sc = (LAS float*)L;
        LAS float* part = (LAS float*)(L + 65536);
        for (int e = tid; e < NB * DM; e += 512) { const int b = e >> 10, k = e & 1023; const float cv = (b < NBP) ? q->cp[b * DM + k] : q->cs[(b - NBP) * DM + k]; sc[e] = cv / (1.0f + expf(-cv)); }
        __syncthreads();
        for (int it = bx; it < 2 * 96; it += G) {
            const int i = it / 96, n0 = (it % 96) * 32, col = lane & 31, kh = lane >> 5;
            const float* wp = q->ada_w + (size_t)i * DM * 3072 + n0 + col;
            float acc[NB];
#pragma unroll
            for (int b = 0; b < NB; ++b) acc[b] = 0.f;
#pragma unroll 4
            for (int kk = 0; kk < 64; ++kk) { const int k = wave * 128 + 2 * kk + kh; const float wv = wp[(size_t)k * 3072];
#pragma unroll
                for (int b = 0; b < NB; ++b) acc[b] += sc[b * DM + k] * wv; }
#pragma unroll
            for (int b = 0; b < NB; ++b) { acc[b] += __shfl_xor(acc[b], 32); if (lane < 32) part[(wave * NB + b) * 32 + col] = acc[b]; }
            __syncthreads();
            if (tid < NB * 32) { const int b = tid >> 5, c2 = tid & 31; float s = q->ada_b[i * 3072 + n0 + c2];
#pragma unroll
                for (int w = 0; w < 8; ++w) s += part[(w * NB + b) * 32 + c2];
                mod[(size_t)(b * 2 + i) * 3072 + n0 + c2] = s; }
            __syncthreads();
        }
        { LAS float* As = (LAS float*)L;
          LAS float* Bs = (LAS float*)(L + 16384);
          const int t_ = tid, d = t_ & 63, kq = t_ >> 6;
          for (int it = bx; it < 256; it += G) {
              const int gi = it >> 6, k0 = ((it >> 2) & 15) * 64, d0 = (it & 3) * 64;
              float acc[8];
#pragma unroll
              for (int i = 0; i < 8; ++i) acc[i] = 0.f;
              for (int c0 = 0; c0 < 256; c0 += 32) {
#pragma unroll
                  for (int j = 0; j < 4; ++j) { const int e = t_ + 512 * j; As[(e >> 5) * 33 + (e & 31)] = q->pool_w_in[(size_t)(k0 + (e >> 5)) * 2048 + gi * 256 + c0 + (e & 31)];
                      Bs[e] = q->pool_w_group[(size_t)gi * 65536 + (size_t)(c0 + (e >> 6)) * 256 + d0 + (e & 63)]; }
                  __syncthreads();
#pragma unroll 8
                  for (int cc = 0; cc < 32; ++cc) { const float bv = Bs[cc * 64 + d];
#pragma unroll
                      for (int i = 0; i < 8; ++i) acc[i] += As[(kq * 8 + i) * 33 + cc] * bv; }
                  __syncthreads();
              }
              u32x4 w; w.x = pk2(acc[0], acc[1]); w.y = pk2(acc[2], acc[3]); w.z = pk2(acc[4], acc[5]); w.w = pk2(acc[6], acc[7]);
              *(u32x4*)(Wpin + (size_t)(gi * 256 + d0 + d) * DM + k0 + kq * 8) = w;
          } }
    }
    SEAM(0);
    if (IN(1)) { PP();
        for (int n = gw; n < 2048; n += NGW) {
            const u32x4 w0 = *(const u32x4*)(Wpin + (size_t)n * DM + lane * 8), w1 = *(const u32x4*)(Wpin + (size_t)n * DM + 512 + lane * 8);
            for (int b = 0; b < NB; ++b) { const float* sh = mod + (size_t)(b * 2 + 1) * 3072;
                const f32x4 a0 = *(const f32x4*)(sh + lane * 8), a1 = *(const f32x4*)(sh + lane * 8 + 4), a2 = *(const f32x4*)(sh + 512 + lane * 8), a3 = *(const f32x4*)(sh + 512 + lane * 8 + 4);
                float t = a0[0] * bf_lo(w0.x) + a0[1] * bf_hi(w0.x) + a0[2] * bf_lo(w0.y) + a0[3] * bf_hi(w0.y) + a1[0] * bf_lo(w0.z) + a1[1] * bf_hi(w0.z) + a1[2] * bf_lo(w0.w) + a1[3] * bf_hi(w0.w)
                        + a2[0] * bf_lo(w1.x) + a2[1] * bf_hi(w1.x) + a2[2] * bf_lo(w1.y) + a2[3] * bf_hi(w1.y) + a3[0] * bf_lo(w1.z) + a3[1] * bf_hi(w1.z) + a3[2] * bf_lo(w1.w) + a3[3] * bf_hi(w1.w);
                t = wave_sum(t); if (lane == 0) SWv[(size_t)b * 2048 + n] = t; }
        }
        modnorm_phase(q->xp, q->xs, q->norm_g, mod, 0, Hb, gw, NGW, lane); }
    SEAM(1);
    if (IN(2)) { PP();
        pg8::Gemm g{Hb, Win, M, N_IN, DM, DM, 0}; pg8::StaticOrder S; S.init(M, N_IN, G, bx);
        pg8::EpiQKVG E{ws + WS_Q, ws + WS_K, ws + WS_V, Gb, q->qg, q->kg, rope, (LAS float*)(L + XCH_OFF)};
        pg8::gemm_phase<pg8::EpiQKVG, pg8::StaticOrder>(L, g, S, E, wave);
    }
    SEAM(2);
    if (IN(3)) { PP();
        constexpr int NU = NB * NH * (SEQ / 256);
#define UNIT(i_, b_, h_, qb_) ((G == 256) ? ((i_) < NU / 256 ? ((b_) = ((bx & 7) * (NU / 256) + (i_)) >> 3, (h_) = ((bx & 7) * (NU / 256) + (i_)) & 7, (qb_) = bx >> 3, true) : false) \
                                        : ((i_) * G + bx < NU ? ((qb_) = ((i_) * G + bx) & 31, (b_) = (((i_) * G + bx) >> 5) >> 3, (h_) = (((i_) * G + bx) >> 5) & 7, true) : false))
        att8::v8i qr[2]; int b = 0, h = 0, qb = 0;
        bool have = UNIT(0, b, h, qb);
        if (have) { const int ln = lane; att8::load_q(qr, ws + WS_Q + ((size_t)b * SEQ + (size_t)qb * 256) * DM + h * HD, wave, ln & 31, ln >> 5); }
        for (int i = 0; have; ++i) {
            int bn = 0, hn = 0, qbn = 0; const bool hn_ok = UNIT(i + 1, bn, hn, qbn);
            const size_t m0 = (size_t)b * SEQ + (size_t)qb * 256, qo = m0 * DM + h * HD, ko = (size_t)b * SEQ * KVD + (h >> 2) * HD;
            const size_t m0n = (size_t)bn * SEQ + (size_t)qbn * 256, qon = m0n * DM + hn * HD, kon = (size_t)bn * SEQ * KVD + (hn >> 2) * HD;
            att8::body(ws + WS_Q + qo, ws + WS_K + ko, ws + WS_V + (size_t)(b * 2 + (h >> 2)) * 128 * 8192, Gb + qo, Hb + qo, SEQ, (char*)lds, wave,
                       qr, i > 0, hn_ok, ws + WS_Q + qon, ws + WS_K + kon, ws + WS_V + (size_t)(bn * 2 + (hn >> 2)) * 128 * 8192);
            b = bn; h = hn; qb = qbn; have = hn_ok;
        }
#undef UNIT
    }
    SEAM(3);
    if (IN(4)) { PP();
        pg8::Gemm g{Hb, Wao, M, DM, DM, DM, 0}; pg8::StaticOrder S; S.init(M, DM, G, bx);
        pg8::EpiX1 E{q->xp, q->xs, q->out, Qb, mod, q->norm_g + DM, RSS};
        pg8::gemm_phase<pg8::EpiX1, pg8::StaticOrder>(L, g, S, E, wave);
    }
    SEAM(4);
    if (IN(5)) { PP();
        pg8::Gemm g{Qb, Wpin, M, 2 * DM, DM, DM, 0}; pg8::StaticOrder S; S.init(M, 2 * DM, G, bx);
        pg8::EpiPoolIn E{Hb, Gb, RSS, SWv};
        pg8::gemm_phase<pg8::EpiPoolIn, pg8::StaticOrder>(L, g, S, E, wave);
    }
    SEAM(5);
    if (IN(6)) { PP(); pool_gate_phase(Hb, Gb, q->pool_scale, Qb, (long)gw * 64 + lane, (long)NGW * 64); }
    SEAM(6);
    if (IN(7)) { PP();
        pg8::Gemm g{Qb, Wpo, M, DM, DM, DM, 0}; pg8::StaticOrder S; S.init(M, DM, G, bx);
        pg8::EpiResGate E{q->out, q->out + (size_t)MP * DM, q->out, mod, 1};
        pg8::gemm_phase<pg8::EpiResGate, pg8::StaticOrder>(L, g, S, E, wave);
    }
#undef IN
#undef SEAM
#undef lane
#undef tid
#undef PP
#undef mod
#undef rope
#undef Win
#undef Wao
#undef Wpin
#undef SWv
#undef RSS
#undef Wpo
#undef Hb
#undef Qb
#undef Kb
#undef Vb
#undef Gb
}

extern "C" void kernel_launch(void* const* d_in, const int* in_sizes, int n_in, void* d_out, int out_size, void* d_ws, size_t ws_size, hipStream_t stream) {
    static int grid = 0;
    if (grid == 0) {
        if (n_in != 15 || in_sizes[0] != MP * DM || in_sizes[1] != (M - MP) * DM || out_size != M * DM || ws_size < WS_END) {
            fprintf(stderr, "kernel_launch: shape mismatch (n_in %d, in0 %d, in1 %d, out %d, ws %zu)\n", n_in, n_in > 0 ? in_sizes[0] : -1, n_in > 1 ? in_sizes[1] : -1, out_size, ws_size); grid = -1; return; }
        int dev = 0, cus = 0, per_cu = 0;
        hipGetDevice(&dev); hipDeviceGetAttribute(&cus, hipDeviceAttributeMultiprocessorCount, dev);
        if (hipFuncSetAttribute((const void*)fwd_megakernel, hipFuncAttributeMaxDynamicSharedMemorySize, LDS_BYTES) != hipSuccess) { fprintf(stderr, "kernel_launch: hipFuncSetAttribute failed\n"); grid = -1; return; }
        if (hipOccupancyMaxActiveBlocksPerMultiprocessor(&per_cu, (const void*)fwd_megakernel, 512, LDS_BYTES) != hipSuccess || per_cu < 1) { fprintf(stderr, "kernel_launch: occupancy query gave %d\n", per_cu); per_cu = 1; }
        (void)hipGetLastError();
        grid = cus * per_cu;
    }
    if (grid < 0) return;
    Params p{};
    p.xp = (const float*)d_in[0]; p.xs = (const float*)d_in[1]; p.cp = (const float*)d_in[2]; p.cs = (const float*)d_in[3]; p.norm_g = (const float*)d_in[4];
    p.ada_w = (const float*)d_in[5]; p.ada_b = (const float*)d_in[6]; p.attn_w_in = (const float*)d_in[7]; p.qg = (const float*)d_in[8]; p.kg = (const float*)d_in[9];
    p.attn_w_out = (const float*)d_in[10]; p.pool_w_in = (const float*)d_in[11]; p.pool_w_group = (const float*)d_in[12]; p.pool_scale = (const float*)d_in[13]; p.pool_w_out = (const float*)d_in[14];
    p.out = (float*)d_out; p.ws = (unsigned char*)d_ws;
#if MK_N_LAUNCHES == 1
    p.ph_lo = 0; p.ph_hi = NPHASE;
    void* args[] = {&p};
    hipError_t e = hipLaunchCooperativeKernel((const void*)fwd_megakernel, dim3(grid), dim3(512), args, LDS_BYTES, stream);
    if (e != hipSuccess) fprintf(stderr, "kernel_launch: cooperative launch failed: %s (grid %d)\n", hipGetErrorString(e), grid);
#else
    for (int k = 0; k < NPHASE; ++k) {
        p.ph_lo = k; p.ph_hi = k + 1;
        hipLaunchKernelGGL(fwd_megakernel, dim3(grid), dim3(512), LDS_BYTES, stream, p);
    }
#endif
}
```

```cpp
#include <hip/hip_runtime.h>
#include <hip/hip_cooperative_groups.h>
#include <cstdio>
#include <cstdint>
namespace cg = cooperative_groups;

#ifndef MK_N_LAUNCHES
#define MK_N_LAUNCHES 1
#endif

constexpr int DM = 1024, SEQ = 8192, NB = 10, NBP = 2, M = NB * SEQ, MP = NBP * SEQ;
constexpr int NH = 8, HD = 128, KVD = 256, N_IN = 2560;
constexpr float RMS_EPS = 1e-6f;
constexpr int NPHASE = 8;
constexpr float QSCALE = 8.0f * 0.088388347648318440f * 1.4426950408889634f;

#define LAS __attribute__((address_space(3)))
typedef unsigned short bf16_t;
typedef short bf16x8 __attribute__((ext_vector_type(8)));
typedef short s16x4 __attribute__((ext_vector_type(4)));
typedef float f32x4 __attribute__((ext_vector_type(4)));
typedef float f32x16 __attribute__((ext_vector_type(16)));
typedef unsigned u32x4 __attribute__((ext_vector_type(4)));
typedef unsigned u32x2 __attribute__((ext_vector_type(2)));

__device__ __forceinline__ unsigned cvt_pk_bf16(float lo, float hi) { unsigned r; asm volatile("v_cvt_pk_bf16_f32 %0, %1, %2" : "=v"(r) : "v"(lo), "v"(hi)); return r; }
__device__ __forceinline__ float bf_lo(unsigned w) { return __uint_as_float(w << 16); }
__device__ __forceinline__ float bf_hi(unsigned w) { return __uint_as_float(w & 0xffff0000u); }
__device__ __forceinline__ int lane_id() { return (int)__builtin_amdgcn_mbcnt_hi(~0u, __builtin_amdgcn_mbcnt_lo(~0u, 0u)); }
__device__ __forceinline__ float sum_fq4(float s) {
    { auto r = __builtin_amdgcn_permlane16_swap(__float_as_uint(s), __float_as_uint(s), false, false); s = __uint_as_float(r[0]) + __uint_as_float(r[1]); }
    { auto r = __builtin_amdgcn_permlane32_swap(__float_as_uint(s), __float_as_uint(s), false, false); s = __uint_as_float(r[0]) + __uint_as_float(r[1]); }
    return s;
}
__device__ __forceinline__ float silu_f(float x) { return x * __builtin_amdgcn_rcpf(1.0f + __builtin_amdgcn_exp2f(-1.4426950408889634f * x)); }

namespace pg8 {
constexpr int BM = 256, BK = 64, HALF = 128, HTB = HALF * BK * 2, STAGE_BYTES = 8 * HTB, NXCD = 8, WGM = 8;

__host__ __device__ __forceinline__ int lds_byte(int r, int c) { const int st = (r >> 4) * 2 + (c >> 5), rr = r & 15, cc = c & 31, ob = rr * 64 + cc * 2; return st * 1024 + (ob ^ (((ob >> 9) & 1) << 5)); }
__host__ __device__ __forceinline__ void stage_rc(int b, int& R, int& C) { const int st = b / 1024, sb = b % 1024, swz = sb ^ (((sb >> 9) & 1) << 5); R = (st >> 1) * 16 + swz / 64; C = (st & 1) * 32 + (swz % 64) / 2; }
__host__ __device__ __forceinline__ int perm32(int rho) { const int n = rho >> 4, i = rho & 15; return 8 * (i >> 2) + 4 * n + (i & 3); }

struct Unit { int pm, pn; };
struct Gemm { const bf16_t* A; const bf16_t* Bt; int M, N, K, lda; size_t apn; };

struct StaticOrder {
    int nM, nN, nwg, G, c;
    __host__ __device__ void init(int M_, int N_, int G_, int c_) { nM = M_ / BM; nN = N_ / BM; nwg = nM * nN; G = G_; c = c_; }
    __host__ __device__ bool next(int i, Unit& u) const {
        const long L = (long)i * G + c; if (L >= nwg) return false;
        int wgid = (int)L; { const int q = nwg / NXCD, r = nwg % NXCD, xcd = wgid % NXCD, off = wgid / NXCD; wgid = (xcd < r ? xcd * (q + 1) : r * (q + 1) + (xcd - r) * q) + off; }
        const int nig = WGM * nN, gid = wgid / nig, fm = gid * WGM, gsz = (nM - fm) < WGM ? (nM - fm) : WGM;
        u.pm = fm + ((wgid % nig) % gsz); u.pn = (wgid % nig) / gsz; return true;
    }
};


struct EpiPoolIn {
    static constexpr bool PERM = true;
    bf16_t* Z; bf16_t* G2; const float* rowss; const float* sw;
    __device__ __forceinline__ void operator()(const f32x4 (&acc)[2][2][4][2], const Unit& u, int wr, int wc, int fr, int fq) const {
        const int row0 = u.pm * BM + wr * 64 + fr, b = (u.pm * BM) / SEQ;
        const float* swp = sw + (size_t)b * 2048 + u.pn * BM + wc * 32 + 8 * fq;
        bf16_t* base = ((u.pn < 4) ? Z : G2) + (u.pn & 3) * BM + wc * 32 + 8 * fq;
        float rs[2][4]; f32x4 s4[2][2];
#pragma unroll
        for (int ai = 0; ai < 2; ++ai)
#pragma unroll
            for (int m = 0; m < 4; ++m) rs[ai][m] = rowss[row0 + ai * HALF + m * 16];
#pragma unroll
        for (int bj = 0; bj < 2; ++bj) { s4[bj][0] = *(const f32x4*)(swp + bj * HALF); s4[bj][1] = *(const f32x4*)(swp + bj * HALF + 4); }
#pragma unroll
        for (int ai = 0; ai < 2; ++ai)
#pragma unroll
            for (int m = 0; m < 4; ++m) { const int row = row0 + ai * HALF + m * 16; const float r_ = __builtin_amdgcn_rsqf(rs[ai][m] * (1.0f / DM) + RMS_EPS);
                bf16_t* rowp = base + (size_t)row * DM;
#pragma unroll
                for (int bj = 0; bj < 2; ++bj) { const f32x4 v0 = acc[ai][bj][m][0] * r_ + s4[bj][0], v1 = acc[ai][bj][m][1] * r_ + s4[bj][1];
                    u32x4 w; w.x = cvt_pk_bf16(v0[0], v0[1]); w.y = cvt_pk_bf16(v0[2], v0[3]); w.z = cvt_pk_bf16(v1[0], v1[1]); w.w = cvt_pk_bf16(v1[2], v1[3]);
                    *(u32x4*)(rowp + bj * HALF) = w; } }
    }
};

struct EpiQKVG {
    static constexpr bool PERM = true;
    unsigned char *Q, *Kb, *V; bf16_t* G; const float* qg; const float* kg; const float* rope; LAS float* X;
    __device__ __forceinline__ void operator()(const f32x4 (&acc)[2][2][4][2], const Unit& u, int wr, int wc, int fr, int fq) const {
        const int hc = wc * 32 + 8 * fq;
        if (u.pn <= 4) {
#pragma unroll
            for (int ai = 0; ai < 2; ++ai)
#pragma unroll
                for (int m = 0; m < 4; ++m)
#pragma unroll
                    for (int bj = 0; bj < 2; ++bj) { const f32x4 a = acc[ai][bj][m][0], b = acc[ai][bj][m][1];
                        float s = (a[0] * a[0] + a[1] * a[1]) + (a[2] * a[2] + a[3] * a[3]) + (b[0] * b[0] + b[1] * b[1]) + (b[2] * b[2] + b[3] * b[3]);
                        s = sum_fq4(s);
                        if (fq == 0) X[((ai * HALF + wr * 64 + m * 16 + fr) * 2 + bj) * 4 + wc] = s; }
            asm volatile("s_waitcnt lgkmcnt(0)" ::: "memory"); __builtin_amdgcn_s_barrier(); asm volatile("" ::: "memory");
            const float* gsrc = (u.pn < 4) ? qg : kg;
            const f32x4 g0 = *(const f32x4*)(gsrc + hc), g1 = *(const f32x4*)(gsrc + hc + 4);
            unsigned char* base; int ldc, colt;
            if (u.pn < 4) { base = Q; ldc = DM; colt = u.pn * BM; } else { base = Kb; ldc = KVD; colt = 0; }
#pragma unroll
            for (int ai = 0; ai < 2; ++ai)
#pragma unroll
                for (int m = 0; m < 4; ++m) { const int lr = ai * HALF + wr * 64 + m * 16 + fr, row = u.pm * BM + lr, spos = row & (SEQ - 1);
                    const f32x4* rp = (const f32x4*)(rope + (size_t)spos * 128 + hc); const f32x4 r0 = rp[0], r1 = rp[1];
#pragma unroll
                    for (int bj = 0; bj < 2; ++bj) { const f32x4 sv = *(const LAS f32x4*)(X + (lr * 2 + bj) * 4);
                        const float rs = __builtin_amdgcn_rsqf(((sv[0] + sv[1]) + (sv[2] + sv[3])) * (1.0f / 128.0f) + RMS_EPS) * (u.pn < 4 ? QSCALE : 1.0f);
                        const f32x4 a = acc[ai][bj][m][0] * rs * g0, b = acc[ai][bj][m][1] * rs * g1;
                        u32x2 w; int t0, t1;
                        t0 = __builtin_amdgcn_cvt_pk_fp8_f32(a[0] * r0[0] - a[1] * r0[1], a[0] * r0[1] + a[1] * r0[0], 0, false);
                        t0 = __builtin_amdgcn_cvt_pk_fp8_f32(a[2] * r0[2] - a[3] * r0[3], a[2] * r0[3] + a[3] * r0[2], t0, true);
                        t1 = __builtin_amdgcn_cvt_pk_fp8_f32(b[0] * r1[0] - b[1] * r1[1], b[0] * r1[1] + b[1] * r1[0], 0, false);
                        t1 = __builtin_amdgcn_cvt_pk_fp8_f32(b[2] * r1[2] - b[3] * r1[3], b[2] * r1[3] + b[3] * r1[2], t1, true);
                        w.x = (unsigned)t0; w.y = (unsigned)t1;
                        *(u32x2*)(base + (size_t)row * ldc + colt + bj * HALF + hc) = w; } }
        } else if (u.pn == 5) {
            const int row0 = u.pm * BM + wr * 64 + fr, b = (u.pm * BM) / SEQ;
#pragma unroll
            for (int ai = 0; ai < 2; ++ai)
#pragma unroll
                for (int m = 0; m < 4; ++m) { const int row = row0 + ai * HALF + m * 16, sp = row & (SEQ - 1);
#pragma unroll
                    for (int bj = 0; bj < 2; ++bj) { const f32x4 v0 = acc[ai][bj][m][0], v1 = acc[ai][bj][m][1];
                        const int kk = sp & 63, kq = kk >> 4, kr = kk & 15, oA = ((kq ^ ((2 * fq) & 3)) << 4) + kr, oB = ((kq ^ ((2 * fq + 1) & 3)) << 4) + kr;
                        unsigned char* vp = V + ((size_t)((b * 2 + bj) * 128 + (sp >> 6)) * 8192 + (size_t)hc * 64);
                        int t0 = __builtin_amdgcn_cvt_pk_fp8_f32(v0[0], v0[1], 0, false); t0 = __builtin_amdgcn_cvt_pk_fp8_f32(v0[2], v0[3], t0, true);
                        int t1 = __builtin_amdgcn_cvt_pk_fp8_f32(v1[0], v1[1], 0, false); t1 = __builtin_amdgcn_cvt_pk_fp8_f32(v1[2], v1[3], t1, true);
                        vp[oA] = (unsigned char)t0; vp[64 + oA] = (unsigned char)(t0 >> 8); vp[128 + oA] = (unsigned char)(t0 >> 16); vp[192 + oA] = (unsigned char)((unsigned)t0 >> 24);
                        vp[256 + oB] = (unsigned char)t1; vp[320 + oB] = (unsigned char)(t1 >> 8); vp[384 + oB] = (unsigned char)(t1 >> 16); vp[448 + oB] = (unsigned char)((unsigned)t1 >> 24); }
                    asm volatile("" ::: "memory"); }
        } else {
            bf16_t* base = G; const int ldc = DM, colt = (u.pn - 6) * BM;
            const int row0 = u.pm * BM + wr * 64 + fr;
#pragma unroll
            for (int ai = 0; ai < 2; ++ai)
#pragma unroll
                for (int m = 0; m < 4; ++m) { bf16_t* rowp = base + (size_t)(row0 + ai * HALF + m * 16) * ldc + colt + hc;
#pragma unroll
                    for (int bj = 0; bj < 2; ++bj) { const f32x4 v0 = acc[ai][bj][m][0], v1 = acc[ai][bj][m][1];
                        u32x4 w; w.x = cvt_pk_bf16(v0[0], v0[1]); w.y = cvt_pk_bf16(v0[2], v0[3]); w.z = cvt_pk_bf16(v1[0], v1[1]); w.w = cvt_pk_bf16(v1[2], v1[3]);
                        *(u32x4*)(rowp + bj * HALF) = w; } }
        }
    }
};

struct EpiResGate {
    static constexpr bool PERM = false;
    const float* xa; const float* xb; float* out; const float* mod; int layer;
    __device__ __forceinline__ void operator()(const f32x4 (&acc)[2][2][4][2], const Unit& u, int wr, int wc, int fr, int fq) const {
        const int row0 = u.pm * BM + wr * 64 + fr, b = (u.pm * BM) / SEQ;
        const int col0 = u.pn * BM + wc * 32 + 4 * fq;
        const float* gt = mod + (size_t)(b * 2 + layer) * 3072 + 2048 + col0;
        f32x4 gv[2][2];
#pragma unroll
        for (int bj = 0; bj < 2; ++bj)
#pragma unroll
            for (int n = 0; n < 2; ++n) gv[bj][n] = *(const f32x4*)(gt + bj * HALF + n * 16);
#pragma unroll
        for (int ai = 0; ai < 2; ++ai) { f32x4 xv[4][2][2];
#pragma unroll
            for (int m = 0; m < 4; ++m) { const int row = row0 + ai * HALF + m * 16;
                const float* xr = (row < MP ? xa + (size_t)row * DM : xb + (size_t)(row - MP) * DM) + col0;
#pragma unroll
                for (int bj = 0; bj < 2; ++bj)
#pragma unroll
                    for (int n = 0; n < 2; ++n) xv[m][bj][n] = *(const f32x4*)(xr + bj * HALF + n * 16); }
#pragma unroll
            for (int m = 0; m < 4; ++m) { float* orow = out + (size_t)(row0 + ai * HALF + m * 16) * DM + col0;
#pragma unroll
                for (int bj = 0; bj < 2; ++bj)
#pragma unroll
                    for (int n = 0; n < 2; ++n) *(f32x4*)(orow + bj * HALF + n * 16) = xv[m][bj][n] + gv[bj][n] * acc[ai][bj][m][n]; }
            asm volatile("" ::: "memory"); }
    }
};

struct EpiX1 {
    static constexpr bool PERM = false;
    const float* xa; const float* xb; float* out; bf16_t* X1A; const float* mod; const float* g1; float* rowss; LAS f32x4* XL;
    __device__ __forceinline__ void operator()(const f32x4 (&acc)[2][2][4][2], const Unit& u, int wr, int wc, int fr, int fq) const {
        const int row0 = u.pm * BM + wr * 64 + fr, b = (u.pm * BM) / SEQ;
        const int col0 = u.pn * BM + wc * 32 + 4 * fq;
        LAS f32x4* xl = XL + (wr * 4 + wc) * 32 + fq * 8;
        if (fr == 0) { const float* gt = mod + (size_t)(b * 2 + 0) * 3072 + 2048 + col0; const float* sc1 = mod + (size_t)(b * 2 + 1) * 3072 + 1024 + col0;
#pragma unroll
            for (int bj = 0; bj < 2; ++bj)
#pragma unroll
                for (int n = 0; n < 2; ++n) { xl[(bj * 2 + n) * 2] = *(const f32x4*)(gt + bj * HALF + n * 16);
                    xl[(bj * 2 + n) * 2 + 1] = *(const f32x4*)(g1 + col0 + bj * HALF + n * 16) * (*(const f32x4*)(sc1 + bj * HALF + n * 16) + 1.0f); } }
        asm volatile("s_waitcnt lgkmcnt(0)" ::: "memory");
#pragma unroll
        for (int ai = 0; ai < 2; ++ai) { f32x4 xv[4][2][2];
#pragma unroll
            for (int m = 0; m < 4; ++m) { const int row = row0 + ai * HALF + m * 16;
                const float* xr = (row < MP ? xa + (size_t)row * DM : xb + (size_t)(row - MP) * DM) + col0;
#pragma unroll
                for (int bj = 0; bj < 2; ++bj)
#pragma unroll
                    for (int n = 0; n < 2; ++n) xv[m][bj][n] = *(const f32x4*)(xr + bj * HALF + n * 16); }
#pragma unroll
            for (int m = 0; m < 4; ++m) { const int row = row0 + ai * HALF + m * 16;
                float* orow = out + (size_t)row * DM + col0; bf16_t* arow = X1A + (size_t)row * DM + col0; float ss = 0.f;
#pragma unroll
                for (int bj = 0; bj < 2; ++bj)
#pragma unroll
                    for (int n = 0; n < 2; ++n) { const f32x4 gv = xl[(bj * 2 + n) * 2], av = xl[(bj * 2 + n) * 2 + 1];
                        const f32x4 o = xv[m][bj][n] + gv * acc[ai][bj][m][n];
                        *(f32x4*)(orow + bj * HALF + n * 16) = o; ss += (o[0] * o[0] + o[1] * o[1]) + (o[2] * o[2] + o[3] * o[3]);
                        const f32x4 y = o * av; u32x2 w; w.x = cvt_pk_bf16(y[0], y[1]); w.y = cvt_pk_bf16(y[2], y[3]); *(u32x2*)(arow + bj * HALF + n * 16) = w; }
                ss = sum_fq4(ss);
                if (fq == 0) (void)__hip_atomic_fetch_add(rowss + row, ss, __ATOMIC_RELAXED, __HIP_MEMORY_SCOPE_AGENT); }
            asm volatile("" ::: "memory"); }
    }
};

template <class Epi, class Sched>
__device__ __forceinline__ void gemm_phase(LAS unsigned char* lds, const Gemm g, const Sched& S, const Epi& E, const int wid) {
    const int lane = lane_id(), tid = wid * 64 + lane, wr = wid >> 2, wc = wid & 3, fr = lane & 15, fq = lane >> 4;
    const int K = g.K, nt = K / BK;
    unsigned voffA[2], voffB[2];
#pragma unroll
    for (int i = 0; i < 2; ++i) { int R, C; stage_rc(tid * 16 + i * 8192, R, C); const int Rb = Epi::PERM ? ((R & ~31) + perm32(R & 31)) : R;
        voffA[i] = (unsigned)(R * g.lda + C) * 2u; voffB[i] = (unsigned)(Rb * K + C) * 2u; }
    const size_t kstep = (size_t)(BK * 2);
    const size_t hstepA = (size_t)HALF * g.lda * 2, hstepB = (size_t)HALF * K * 2;
    const size_t tstepA = 2 * hstepA, tstepB = 2 * hstepB;
    const unsigned ldsw = (unsigned)wid * 1024u;
    const int aoff = lds_byte(wr * 64 + fr, fq * 8), boff = lds_byte(wc * 32 + fr, fq * 8);
#define PG8_SA(b, h) (((b) * 2 + (h)) * HTB)
#define PG8_SB(b, h) ((4 + (b) * 2 + (h)) * HTB)
#define PG8_STAGE(bufoff, gbase, voff) do { _Pragma("unroll") for (int _i = 0; _i < 2; ++_i) \
        __builtin_amdgcn_global_load_lds((const unsigned*)((const char*)(gbase) + (voff)[_i]), (LAS unsigned*)(lds + (bufoff) + ldsw + _i * 8192), 16, 0, 0); } while (0)
#define PG8_LDA(dst, b, h) do { _Pragma("unroll") for (int m = 0; m < 4; ++m) _Pragma("unroll") for (int k = 0; k < 2; ++k) dst[m][k] = *(const LAS bf16x8*)(lds + PG8_SA(b, h) + aoff + m * 2048 + k * 1024); } while (0)
#define PG8_LDB(dst, b, h) do { _Pragma("unroll") for (int n = 0; n < 2; ++n) _Pragma("unroll") for (int k = 0; k < 2; ++k) dst[n][k] = *(const LAS bf16x8*)(lds + PG8_SB(b, h) + boff + n * 2048 + k * 1024); } while (0)
#define PG8_MMA(ai, bj, At, Bt) do { __builtin_amdgcn_s_setprio(1); _Pragma("unroll") for (int m = 0; m < 4; ++m) _Pragma("unroll") for (int n = 0; n < 2; ++n) _Pragma("unroll") for (int k = 0; k < 2; ++k) \
        acc[ai][bj][m][n] = __builtin_amdgcn_mfma_f32_16x16x32_bf16(Bt[n][k], At[m][k], acc[ai][bj][m][n], 0, 0, 0); __builtin_amdgcn_s_setprio(0); } while (0)
#define PG8_WAIT_V(n) asm volatile("s_waitcnt vmcnt(" #n ")" ::: "memory")
#define PG8_WAIT_L(n) asm volatile("s_waitcnt lgkmcnt(" #n ")" ::: "memory")
#define PG8_BAR __builtin_amdgcn_s_barrier()
#define PG8_SCHED __builtin_amdgcn_sched_barrier(0)
    Unit cur, nxt; int ui = 0;
    if (!S.next(0, cur)) return;
    f32x4 acc[2][2][4][2];
#pragma unroll
    for (int a = 0; a < 2; ++a)
#pragma unroll
        for (int b = 0; b < 2; ++b)
#pragma unroll
            for (int m = 0; m < 4; ++m)
#pragma unroll
                for (int n = 0; n < 2; ++n) acc[a][b][m][n] = (f32x4){0.f, 0.f, 0.f, 0.f};
    bf16x8 At[4][2], B0[2][2], B1[2][2];
    const char* cA = (const char*)g.A + (size_t)cur.pm * tstepA + (size_t)cur.pn * g.apn; const char* cB = (const char*)g.Bt + (size_t)cur.pn * tstepB;
    PG8_STAGE(PG8_SB(0, 0), cB, voffB); PG8_STAGE(PG8_SB(0, 1), cB + hstepB, voffB); PG8_STAGE(PG8_SA(0, 0), cA, voffA); PG8_STAGE(PG8_SA(0, 1), cA + hstepA, voffA);
    if (wr == 1) PG8_BAR;
    PG8_WAIT_V(2); PG8_BAR;
    PG8_STAGE(PG8_SB(1, 0), cB + kstep, voffB); PG8_STAGE(PG8_SA(1, 0), cA + kstep, voffA); PG8_STAGE(PG8_SB(1, 1), cB + hstepB + kstep, voffB);
    PG8_WAIT_V(6); PG8_BAR;
    for (;;) {
        const bool has_next = S.next(ui + 1, nxt);
        const char* nA = has_next ? (const char*)g.A + (size_t)nxt.pm * tstepA + (size_t)nxt.pn * g.apn : cA; const char* nB = has_next ? (const char*)g.Bt + (size_t)nxt.pn * tstepB : cB;
        for (int t = 0; t < nt; t += 2) {
            const bool last = (t == nt - 2);
            const char* a1 = cA + (size_t)(t + 1) * kstep;
            const char* a2 = last ? nA : cA + (size_t)(t + 2) * kstep; const char* b2 = last ? nB : cB + (size_t)(t + 2) * kstep;
            const char* a3 = a2 + kstep; const char* b3 = b2 + kstep;
            PG8_LDB(B0, 0, 0); PG8_LDB(B1, 0, 1); PG8_SCHED; PG8_LDA(At, 0, 0); PG8_STAGE(PG8_SA(1, 1), a1 + hstepA, voffA);
            PG8_WAIT_V(8); PG8_WAIT_L(0); PG8_BAR; PG8_MMA(0, 0, At, B0); PG8_MMA(0, 1, At, B1); PG8_BAR; PG8_SCHED;
            PG8_LDA(At, 0, 1); PG8_STAGE(PG8_SB(0, 0), b2, voffB); PG8_STAGE(PG8_SB(0, 1), b2 + hstepB, voffB); PG8_STAGE(PG8_SA(0, 0), a2, voffA);
            PG8_WAIT_V(8); PG8_WAIT_L(0); PG8_BAR; PG8_MMA(1, 0, At, B0); PG8_MMA(1, 1, At, B1); PG8_BAR; PG8_SCHED;
            PG8_LDB(B0, 1, 0); PG8_LDB(B1, 1, 1); PG8_SCHED; PG8_LDA(At, 1, 0); PG8_STAGE(PG8_SA(0, 1), a2 + hstepA, voffA);
            PG8_WAIT_V(8); PG8_WAIT_L(0); PG8_BAR; PG8_MMA(0, 0, At, B0); PG8_MMA(0, 1, At, B1); PG8_BAR; PG8_SCHED;
            PG8_LDA(At, 1, 1); PG8_STAGE(PG8_SB(1, 0), b3, voffB); PG8_STAGE(PG8_SB(1, 1), b3 + hstepB, voffB); PG8_STAGE(PG8_SA(1, 0), a3, voffA);
            PG8_WAIT_V(8); PG8_WAIT_L(0); PG8_BAR; PG8_MMA(1, 0, At, B0); PG8_MMA(1, 1, At, B1); PG8_BAR; PG8_SCHED;
        }
        if (wr == 0) PG8_BAR;
        E(acc, cur, wr, wc, fr, fq);
        if (!has_next) break;
#pragma unroll
        for (int a = 0; a < 2; ++a)
#pragma unroll
            for (int b = 0; b < 2; ++b)
#pragma unroll
                for (int m = 0; m < 4; ++m)
#pragma unroll
                    for (int n = 0; n < 2; ++n) acc[a][b][m][n] = (f32x4){0.f, 0.f, 0.f, 0.f};
        cur = nxt; cA = nA; cB = nB; ++ui;
        if (wr == 1) PG8_BAR;
    }
    PG8_WAIT_V(0);
    PG8_BAR;
#undef PG8_SA
#undef PG8_SB
#undef PG8_STAGE
#undef PG8_LDA
#undef PG8_LDB
#undef PG8_MMA
#undef PG8_WAIT_V
#undef PG8_WAIT_L
#undef PG8_BAR
#undef PG8_SCHED
}
}

#define SBAR() __builtin_amdgcn_sched_barrier(0)

namespace att8 {
typedef int v8i __attribute__((ext_vector_type(8)));
constexpr int NW = 8, QBLK = 32, KVBLK = 64;
constexpr float SCALE = 0.088388347648318440f;
constexpr float THR = 2.f;
constexpr float PSHIFT = 5.f;
constexpr float THR2 = THR * 1.4426950408889634f;
constexpr int LDO = DM;
constexpr int SHM_T = 8192, K_OFF = 4 * SHM_T, WS_OFF = 8 * SHM_T, ST_OFF = WS_OFF + NW * 64 * 4, ST_ROW = 272;
static_assert(ST_OFF + NW * QBLK * ST_ROW <= 147456, "attention LDS");
#define SCL1 0x7F7F7F7F
#define MFMA8(A, B, C) __builtin_amdgcn_mfma_scale_f32_32x32x64_f8f6f4(A, B, C, 0, 0, 0, SCL1, 0, SCL1)
#define MFMA8Q(A, B, C) __builtin_amdgcn_mfma_scale_f32_32x32x64_f8f6f4(A, B, C, 0, 0, 0, SCL1, 0, 0x7C7C7C7C)
__device__ __forceinline__ int crow(int r, int hi) { return (r & 3) + 8 * (r >> 2) + 4 * hi; }
__device__ __forceinline__ v8i ld32(const char* p0, const char* p1) { const u32x4 a = *(const u32x4*)p0, b = *(const u32x4*)p1; return (v8i){(int)a.x, (int)a.y, (int)a.z, (int)a.w, (int)b.x, (int)b.y, (int)b.z, (int)b.w}; }

__device__ __forceinline__ float max32(const f32x16& p0, const f32x16& p1) {
  float m = p0[0]; for (int r = 1; r < 16; ++r) m = fmaxf(m, p0[r]); for (int r = 0; r < 16; ++r) m = fmaxf(m, p1[r]);
  { auto rr = __builtin_amdgcn_permlane32_swap(__float_as_uint(m), __float_as_uint(m), false, false);
    m = fmaxf(__uint_as_float(rr[0]), __uint_as_float(rr[1])); }
  return m;
}
__device__ __forceinline__ void adjustSM(f32x16& p0, f32x16& p1, f32x16& nm, float& alpha, const float pmax) {
  alpha = 1.f;
  if (__builtin_expect(__any(pmax > PSHIFT + THR2), 0)) {
    const float delta = (pmax > PSHIFT + THR2) ? (pmax - PSHIFT) : 0.f;
    alpha = __builtin_amdgcn_exp2f(-delta);
    for (int r = 0; r < 16; ++r) { p0[r] -= delta; p1[r] -= delta; nm[r] -= delta; }
  }
}
__device__ __forceinline__ void exp16(f32x16& p0) { for (int r = 0; r < 16; ++r) p0[r] = __builtin_amdgcn_exp2f(p0[r]); }
__device__ __forceinline__ void partialSM_first(f32x16& p0, f32x16& p1, f32x16& nm) {
  const float delta = max32(p0, p1) - PSHIFT;
  for (int r = 0; r < 16; ++r) { p0[r] -= delta; p1[r] -= delta; nm[r] -= delta; }
  for (int r = 0; r < 16; ++r) p0[r] = __builtin_amdgcn_exp2f(p0[r]);
}
__device__ __forceinline__ void finishSM(f32x16& p0, f32x16& p1, v8i& pf) {
  for (int r = 0; r < 16; ++r) p1[r] = __builtin_amdgcn_exp2f(p1[r]);
#pragma unroll
  for (int j = 0; j < 4; ++j) {
    int a = __builtin_amdgcn_cvt_pk_fp8_f32(p0[4 * j], p0[4 * j + 1], 0, false); a = __builtin_amdgcn_cvt_pk_fp8_f32(p0[4 * j + 2], p0[4 * j + 3], a, true);
    int b = __builtin_amdgcn_cvt_pk_fp8_f32(p1[4 * j], p1[4 * j + 1], 0, false); b = __builtin_amdgcn_cvt_pk_fp8_f32(p1[4 * j + 2], p1[4 * j + 3], b, true);
    auto rr = __builtin_amdgcn_permlane32_swap((unsigned)a, (unsigned)b, false, false);
    pf[2 * j] = (int)rr[0]; pf[2 * j + 1] = (int)rr[1]; }
}
__device__ __forceinline__ void qkt(f32x16& p0, f32x16& p1, const f32x16& nm, const char* Ks, const v8i* qr, int ko, int c00, int c01, int c10, int c11) {
  { const v8i a0 = ld32(Ks + ko + c00, Ks + ko + c01), a1 = ld32(Ks + 4096 + ko + c00, Ks + 4096 + ko + c01);
    p0 = MFMA8Q(a0, qr[0], nm); p1 = MFMA8Q(a1, qr[0], nm); }
  { const v8i a0 = ld32(Ks + ko + c10, Ks + ko + c11), a1 = ld32(Ks + 4096 + ko + c10, Ks + 4096 + ko + c11);
    p0 = MFMA8Q(a0, qr[1], p0); p1 = MFMA8Q(a1, qr[1], p1); }
}
__device__ __forceinline__ void pv_load(v8i* vf, const char* Vs, int vo, int e0, int e1) {
#pragma unroll
  for (int d0 = 0; d0 < 4; ++d0) vf[d0] = ld32(Vs + d0 * 2048 + vo + e0, Vs + d0 * 2048 + vo + e1);
}
__device__ __forceinline__ void pv_mma(f32x16* o, f32x16& ls, const v8i* vf, const v8i pf) {
#pragma unroll
  for (int d0 = 0; d0 < 4; ++d0) o[d0] = MFMA8(pf, vf[d0], o[d0]);
  const v8i ones = {0x38383838, 0x38383838, 0x38383838, 0x38383838, 0x38383838, 0x38383838, 0x38383838, 0x38383838};
  ls = MFMA8(pf, ones, ls);
}

__device__ __forceinline__ void load_q(v8i (&qr)[2], const unsigned char* Q8b, int wid, int r32, int hi) {
  const char* Qw = (const char*)Q8b + (wid * QBLK + r32) * 1024 + hi * 32;
#pragma unroll
  for (int c = 0; c < 2; ++c) { const u32x4 a = *(const u32x4*)(Qw + c * 64), b = *(const u32x4*)(Qw + c * 64 + 16); qr[c] = (v8i){(int)a.x, (int)a.y, (int)a.z, (int)a.w, (int)b.x, (int)b.y, (int)b.z, (int)b.w}; }
}
__device__ __forceinline__ void body(const unsigned char* Q8b, const unsigned char* K8h, const unsigned char* VT8h, const bf16_t* Gb, bf16_t* Ob, int seq, char* lds, const int wid,
                                     v8i (&qr)[2], const int pre, const int nxt, const unsigned char* Q8n, const unsigned char* K8n, const unsigned char* VT8n) {
  const int lane = lane_id(), tid = wid * 64 + lane, r32 = lane & 31, hi = lane >> 5;
  char* V_lds = lds; char* K_lds = lds + K_OFF;
  float* ws = (float*)(lds + WS_OFF) + wid * 64; float* al_l = ws + 32;
  f32x16 o[4] = {}; f32x16 ls = {}; f32x16 nm;
#pragma unroll
  for (int r = 0; r < 16; ++r) nm[r] = PSHIFT;
  LAS char* L3 = (LAS char*)lds;
  const int krow = wid * 8 + (lane >> 3), kc = (lane & 7) ^ ((krow >> 1) & 7);
  const char* Kg = (const char*)K8h + krow * 256 + kc * 16; const char* Vg = (const char*)VT8h + wid * 1024 + lane * 16;
  const int ksw = (r32 >> 1) & 7, ko = r32 * 128, c00 = ((0 + hi * 2) ^ ksw) << 4, c01 = ((1 + hi * 2) ^ ksw) << 4, c10 = ((4 + hi * 2) ^ ksw) << 4, c11 = ((5 + hi * 2) ^ ksw) << 4;
  const int vsw = (r32 >> 2) & 3, vo = r32 * 64, e0 = ((2 * hi) ^ vsw) << 4, e1 = ((2 * hi + 1) ^ vsw) << 4;
#define DMA(slot, t) do { \
    __builtin_amdgcn_global_load_lds((const unsigned*)(Kg + (long)(t) * (64 * 256)), (LAS unsigned*)(L3 + K_OFF + (slot) * SHM_T + wid * 1024), 16, 0, 0); \
    __builtin_amdgcn_global_load_lds((const unsigned*)(Vg + (long)(t) * 8192), (LAS unsigned*)(L3 + (slot) * SHM_T + wid * 1024), 16, 0, 0); } while (0)
#define BAR() do { asm volatile("s_waitcnt lgkmcnt(0)" ::: "memory"); __builtin_amdgcn_s_barrier(); asm volatile("" ::: "memory"); } while (0)
#define WAITV(n) asm volatile("s_waitcnt vmcnt(" #n ")" ::: "memory")
#define RESC(a) do { if (__any((a) < 1.f)) { if (hi == 0) al_l[r32] = (a); asm volatile("s_waitcnt lgkmcnt(0)" ::: "memory"); \
    for (int r = 0; r < 16; ++r) { const float a_ = al_l[crow(r, hi)]; ls[r] *= a_; for (int d = 0; d < 4; ++d) o[d][r] *= a_; } } } while (0)
#define QKT(P0, P1, b) qkt(P0, P1, nm, K_lds + (b) * SHM_T, qr, ko, c00, c01, c10, c11)
#define SGB(mask, n) __builtin_amdgcn_sched_group_barrier(mask, n, 0)
#define PVL(b) pv_load(vf, V_lds + (b) * SHM_T, vo, e0, e1)
#define PVM() pv_mma(o, ls, vf, pf)
#define PIPE1() do { SGB(0x100, 8); SGB(0x400, 4); SGB(0x008, 1); SGB(0x400, 4); SGB(0x008, 1); SGB(0x400, 4); SGB(0x008, 1); SGB(0x400, 4); SGB(0x008, 1); } while (0)
#define HALF2(Y0, Y1, alY, b) do { PVL(b); const float pm_ = max32(Y0, Y1); adjustSM(Y0, Y1, nm, alY, pm_); SBAR(); \
    PVM(); exp16(Y0); asm volatile("" : "+v"(Y0)); \
    SGB(0x008, 1); SGB(0x400, 3); SGB(0x008, 1); SGB(0x400, 3); SGB(0x008, 1); SGB(0x400, 3); SGB(0x008, 1); SGB(0x400, 3); SGB(0x008, 1); SGB(0x400, 4); SBAR(); } while (0)
  f32x16 pA0, pA1, pB0, pB1; float alA, alB; v8i pf; v8i vf[4]; const int NT = seq / KVBLK;
  if (!pre) { DMA(0, 0); DMA(1, 1); } else BAR();
  DMA(2, 2);
  WAITV(2); BAR();
  QKT(pA0, pA1, 0); partialSM_first(pA0, pA1, nm);
  int s0 = 0;
  for (int i = 0; i + 2 < NT; i += 2) {
    SBAR(); QKT(pB0, pB1, (s0 + 1) & 3);
    finishSM(pA0, pA1, pf); PIPE1(); SBAR();
    DMA((s0 + 3) & 3, i + 3);
    SBAR();
    HALF2(pB0, pB1, alB, s0);
    WAITV(2);
    RESC(alB); BAR();
    SBAR(); QKT(pA0, pA1, (s0 + 2) & 3);
    finishSM(pB0, pB1, pf); PIPE1(); SBAR();
    { const int t4 = (i + 4 < NT) ? i + 4 : NT - 1; DMA(s0, t4); }
    SBAR();
    HALF2(pA0, pA1, alA, (s0 + 1) & 3);
    WAITV(2);
    RESC(alA); BAR();
    s0 = (s0 + 2) & 3;
  }
  SBAR(); QKT(pB0, pB1, (s0 + 1) & 3);
  finishSM(pA0, pA1, pf); SBAR();
  HALF2(pB0, pB1, alB, s0);
  RESC(alB);
  PVL((s0 + 1) & 3); finishSM(pB0, pB1, pf); SBAR();
  PVM();
  WAITV(0);
  if (nxt) {
    load_q(qr, Q8n, wid, r32, hi);
    const char* KgN = (const char*)K8n + krow * 256 + kc * 16; const char* VgN = (const char*)VT8n + wid * 1024 + lane * 16;
#pragma unroll
    for (int tn = 0; tn < 2; ++tn) {
      __builtin_amdgcn_global_load_lds((const unsigned*)(KgN + (long)tn * (64 * 256)), (LAS unsigned*)(L3 + K_OFF + tn * SHM_T + wid * 1024), 16, 0, 0);
      __builtin_amdgcn_global_load_lds((const unsigned*)(VgN + (long)tn * 8192), (LAS unsigned*)(L3 + tn * SHM_T + wid * 1024), 16, 0, 0); }
  }
  float rli[16];
#pragma unroll
  for (int r = 0; r < 16; ++r) rli[r] = __builtin_amdgcn_rcpf(ls[r]);
  const int rw = lane >> 4, ch = lane & 15;
  const bf16_t* Gw = Gb + (wid * QBLK + rw) * LDO + ch * 8; bf16_t* Ow = Ob + (wid * QBLK + rw) * LDO + ch * 8;
  u32x4 gv[8];
#pragma unroll
  for (int i = 0; i < 8; ++i) gv[i] = *(const u32x4*)(Gw + i * 4 * LDO);
  char* st = lds + ST_OFF + wid * (QBLK * ST_ROW) + r32 * 2 + hi * 4 * ST_ROW;
#pragma unroll
  for (int r = 0; r < 16; ++r) {
#pragma unroll
    for (int d0 = 0; d0 < 4; ++d0) *(bf16_t*)(st + ((r & 3) + 8 * (r >> 2)) * ST_ROW + d0 * 64) = (bf16_t)cvt_pk_bf16(o[d0][r] * rli[r], 0.f); }
  asm volatile("s_waitcnt lgkmcnt(0)" ::: "memory");
  { const char* sr2 = lds + ST_OFF + wid * (QBLK * ST_ROW) + rw * ST_ROW + ch * 16;
#pragma unroll
    for (int i = 0; i < 8; ++i) { const u32x4 ov = *(const u32x4*)(sr2 + i * 4 * ST_ROW); const u32x4 g = gv[i];
      u32x4 w;
      w.x = cvt_pk_bf16(bf_lo(ov.x) * silu_f(bf_lo(g.x)), bf_hi(ov.x) * silu_f(bf_hi(g.x)));
      w.y = cvt_pk_bf16(bf_lo(ov.y) * silu_f(bf_lo(g.y)), bf_hi(ov.y) * silu_f(bf_hi(g.y)));
      w.z = cvt_pk_bf16(bf_lo(ov.z) * silu_f(bf_lo(g.z)), bf_hi(ov.z) * silu_f(bf_hi(g.z)));
      w.w = cvt_pk_bf16(bf_lo(ov.w) * silu_f(bf_lo(g.w)), bf_hi(ov.w) * silu_f(bf_hi(g.w)));
      *(u32x4*)(Ow + i * 4 * LDO) = w; } }
#undef DMA
#undef BAR
#undef WAITV
#undef RESC
#undef QKT
#undef PIPE1
#undef PVL
#undef PVM
#undef SGB
#undef HALF2
}
}

constexpr size_t MiB = 1u << 20;
constexpr size_t WS_BAR = 0;
constexpr size_t WS_MOD = 1 * MiB;
constexpr size_t WS_ROPE = 2 * MiB;
constexpr size_t WS_WIN = 6 * MiB;
constexpr size_t WS_WAO = 11 * MiB;
constexpr size_t WS_WPIN = 13 * MiB;
constexpr size_t WS_SW = 20 * MiB;
constexpr size_t WS_RSS = 21 * MiB;
constexpr size_t WS_WPO = 18 * MiB;
constexpr size_t WS_H = 32 * MiB;
constexpr size_t WS_Q = 192 * MiB;
constexpr size_t WS_K = 352 * MiB;
constexpr size_t WS_V = 392 * MiB;
constexpr size_t WS_G = 432 * MiB;
constexpr size_t WS_END = 592 * MiB;

constexpr int RING_BYTES = 131072, XCH_OFF = RING_BYTES, LDS_BYTES = 147456, MISC_OFF = LDS_BYTES - 256;

struct Params {
    const float *xp, *xs, *cp, *cs, *norm_g, *ada_w, *ada_b, *attn_w_in, *qg, *kg, *attn_w_out, *pool_w_in, *pool_w_group, *pool_scale, *pool_w_out;
    float* out; unsigned char* ws; int ph_lo, ph_hi;
};

__device__ __forceinline__ float wave_sum(float v) {
#pragma unroll
    for (int o = 1; o < 64; o <<= 1) v += __shfl_xor(v, o);
    return v;
}
__device__ __forceinline__ unsigned f2bf(float f) { unsigned u = __builtin_bit_cast(unsigned, f); return (u + 0x7fffu + ((u >> 16) & 1u)) >> 16; }
__device__ __forceinline__ unsigned pk2(float lo, float hi) { return f2bf(lo) | (f2bf(hi) << 16); }

__device__ __forceinline__ void p0_transpose_item(const float* W, int K, int N, int ldw, bf16_t* WT, int row_off, LAS float* scr, int item, int lane) {
    const int nblk = N / 32, kb = item / nblk, nb = item % nblk, k0 = 64 * kb, n0 = 32 * nb;
#pragma unroll 8
    for (int i = 0; i < 32; ++i) { const int kk = 2 * i + (lane >> 5); scr[kk * 33 + (lane & 31)] = W[(size_t)(k0 + kk) * ldw + n0 + (lane & 31)]; }
    asm volatile("s_waitcnt lgkmcnt(0)" ::: "memory");
    const int c = lane & 7;
#pragma unroll
    for (int j = 0; j < 4; ++j) { const int n = (lane >> 3) + 8 * j; const LAS float* s = scr + (8 * c) * 33 + n;
        u32x4 o; o.x = pk2(s[0 * 33], s[1 * 33]); o.y = pk2(s[2 * 33], s[3 * 33]); o.z = pk2(s[4 * 33], s[5 * 33]); o.w = pk2(s[6 * 33], s[7 * 33]);
        *(u32x4*)(WT + (size_t)(row_off + n0 + n) * K + k0 + 8 * c) = o; }
    asm volatile("s_waitcnt lgkmcnt(0)" ::: "memory");
}

__device__ __forceinline__ void modnorm_phase(const float* xa, const float* xb, const float* g, const float* mod, int layer, bf16_t* H, int gw, int NGW, int lane) {
    const int per = (((M + NGW - 1) / NGW) + 7) & ~7; const int r0 = gw * per; int r1 = r0 + per; if (r1 > M) r1 = M;
    int curb = -1; f32x4 a[4], sh[4];
    for (int m = r0; m < r1; m += 8) {
        const int b = m / SEQ;
        if (b != curb) { curb = b; const float* md = mod + (size_t)(b * 2 + layer) * 3072;
#pragma unroll
            for (int j = 0; j < 4; ++j) { const f32x4 gv = ((const f32x4*)g)[lane + 64 * j], sc = ((const f32x4*)(md + 1024))[lane + 64 * j];
                a[j] = gv * (sc + 1.0f); sh[j] = ((const f32x4*)md)[lane + 64 * j]; } }
        const float* xrow = (m < MP) ? xa + (size_t)m * DM : xb + (size_t)(m - MP) * DM;
        f32x4 v[8][4]; float s[8];
#pragma unroll
        for (int r = 0; r < 8; ++r) { const f32x4* xr = (const f32x4*)(xrow + (size_t)r * DM) + lane;
#pragma unroll
            for (int j = 0; j < 4; ++j) v[r][j] = xr[64 * j]; }
#pragma unroll
        for (int r = 0; r < 8; ++r) { float t = 0.f;
#pragma unroll
            for (int j = 0; j < 4; ++j) t += (v[r][j][0] * v[r][j][0] + v[r][j][1] * v[r][j][1]) + (v[r][j][2] * v[r][j][2] + v[r][j][3] * v[r][j][3]);
            s[r] = t; }
#pragma unroll
        for (int o = 1; o < 64; o <<= 1) {
#pragma unroll
            for (int r = 0; r < 8; ++r) s[r] += __shfl_xor(s[r], o); }
#pragma unroll
        for (int r = 0; r < 8; ++r) { const float rstd = 1.0f / sqrtf(s[r] * (1.0f / DM) + RMS_EPS);
            u32x2* o8 = (u32x2*)(H + (size_t)(m + r) * DM) + lane;
#pragma unroll
            for (int j = 0; j < 4; ++j) { const f32x4 y = v[r][j] * rstd * a[j] + sh[j]; u32x2 w; w.x = cvt_pk_bf16(y[0], y[1]); w.y = cvt_pk_bf16(y[2], y[3]); o8[64 * j] = w; } }
    }
}

constexpr int PR = 16;
#define ACC8(S, OP, V) do { S[0] OP bf_lo(V.x); S[1] OP bf_hi(V.x); S[2] OP bf_lo(V.y); S[3] OP bf_hi(V.y); S[4] OP bf_lo(V.z); S[5] OP bf_hi(V.z); S[6] OP bf_lo(V.w); S[7] OP bf_hi(V.w); } while (0)
__device__ __forceinline__ void pool_gate_phase(const bf16_t* Z, const bf16_t* G2, const float* scale, bf16_t* O, long gtid, long NT) {
    for (long it = gtid; it < (long)(M / PR) * 128; it += NT) {
        const int ch = (int)(it & 127), m0 = (int)(it >> 7) * PR, hw = 1 << (ch >> 5), s0 = m0 & (SEQ - 1);
        const size_t seq0 = (size_t)(m0 - s0) * DM + ch * 8;
        const bf16_t* zb = Z + seq0; const bf16_t* gb = G2 + seq0; bf16_t* ob = O + seq0;
        const f32x4 sc0 = *(const f32x4*)(scale + ch * 8), sc1 = *(const f32x4*)(scale + ch * 8 + 4);
        float sum[8];
#pragma unroll
        for (int i = 0; i < 8; ++i) sum[i] = 0.f;
        { int lo = s0 - hw, hi = s0 + hw; if (lo < 0) lo = 0; if (hi > SEQ) hi = SEQ;
          for (int r = lo; r < hi; ++r) { const u32x4 v = *(const u32x4*)(zb + (size_t)r * DM); ACC8(sum, +=, v); } }
#pragma unroll
        for (int tb = 0; tb < PR; tb += 8) {
            u32x4 c[8], gt[8], ve[8], vl[8]; float me[8], ml[8], inv[8];
#pragma unroll
            for (int k = 0; k < 8; ++k) { const int t = s0 + tb + k;
                c[k] = *(const u32x4*)(zb + (size_t)t * DM); gt[k] = *(const u32x4*)(gb + (size_t)t * DM);
                int lo = t - hw, hi = t + hw; me[k] = hi < SEQ ? 1.f : 0.f; ml[k] = lo >= 0 ? 1.f : 0.f; if (lo < 0) lo = 0; if (hi > SEQ - 1) hi = SEQ - 1;
                ve[k] = *(const u32x4*)(zb + (size_t)hi * DM); vl[k] = *(const u32x4*)(zb + (size_t)lo * DM);
                inv[k] = 1.0f / (float)((t + hw > SEQ ? SEQ : t + hw) - lo); }
#pragma unroll
            for (int k = 0; k < 8; ++k) { const int t = s0 + tb + k; const u32x4 cc = c[k], g = gt[k]; const float iv = inv[k];
                u32x4 w;
                w.x = cvt_pk_bf16((sum[0] * iv - bf_lo(cc.x)) * sc0[0] * silu_f(bf_lo(g.x)), (sum[1] * iv - bf_hi(cc.x)) * sc0[1] * silu_f(bf_hi(g.x)));
                w.y = cvt_pk_bf16((sum[2] * iv - bf_lo(cc.y)) * sc0[2] * silu_f(bf_lo(g.y)), (sum[3] * iv - bf_hi(cc.y)) * sc0[3] * silu_f(bf_hi(g.y)));
                w.z = cvt_pk_bf16((sum[4] * iv - bf_lo(cc.z)) * sc1[0] * silu_f(bf_lo(g.z)), (sum[5] * iv - bf_hi(cc.z)) * sc1[1] * silu_f(bf_hi(g.z)));
                w.w = cvt_pk_bf16((sum[6] * iv - bf_lo(cc.w)) * sc1[2] * silu_f(bf_lo(g.w)), (sum[7] * iv - bf_hi(cc.w)) * sc1[3] * silu_f(bf_hi(g.w)));
                *(u32x4*)(ob + (size_t)t * DM) = w;
                const u32x4 e_ = ve[k], l_ = vl[k]; const float a_ = me[k], b_ = ml[k];
                sum[0] += a_ * bf_lo(e_.x) - b_ * bf_lo(l_.x); sum[1] += a_ * bf_hi(e_.x) - b_ * bf_hi(l_.x); sum[2] += a_ * bf_lo(e_.y) - b_ * bf_lo(l_.y); sum[3] += a_ * bf_hi(e_.y) - b_ * bf_hi(l_.y);
                sum[4] += a_ * bf_lo(e_.z) - b_ * bf_lo(l_.z); sum[5] += a_ * bf_hi(e_.z) - b_ * bf_hi(l_.z); sum[6] += a_ * bf_lo(e_.w) - b_ * bf_lo(l_.w); sum[7] += a_ * bf_hi(e_.w) - b_ * bf_hi(l_.w); }
            asm volatile("" ::: "memory");
        }
    }
}


#define XB_TMO      128
#define XB_XCNT(j)  (256  + 64 * (j))
#define XB_XSUB(j)  (1280 + 64 * (j))
#define XB_XGEN(j)  (2304 + 64 * (j))
#define XB_TOP      3328
#define XB_TOPGEN   3392
#define XCD_BAR_WORDS 3456
#define XB_SPIN_CAP (1u << 18)
__device__ __forceinline__ unsigned xb_ld(unsigned* p)              { return __hip_atomic_load(p, __ATOMIC_RELAXED, __HIP_MEMORY_SCOPE_AGENT); }
__device__ __forceinline__ unsigned xb_add(unsigned* p, unsigned v) { return __hip_atomic_fetch_add(p, v, __ATOMIC_RELAXED, __HIP_MEMORY_SCOPE_AGENT); }
__device__ __forceinline__ unsigned xb_xcc_id() { return (unsigned)__builtin_amdgcn_s_getreg((3 << 11) | 20) & 0xFu; }
#define XB_SPIN(cond, bar) do { unsigned _sp = 0; while (cond) { __builtin_amdgcn_s_sleep(1); \
    if ((++_sp & 255u) == 0u) { if (xb_ld(&(bar)[XB_TMO])) break; if (_sp > XB_SPIN_CAP) { atomicAdd(&(bar)[XB_TMO], 1u); break; } } } } while (0)
__device__ __forceinline__ void xcd_barrier_complete(unsigned* bar, unsigned x, unsigned& nloc, unsigned& nx) {
    const unsigned G = gridDim.x * gridDim.y * gridDim.z;
    unsigned sum, cnt, mine, sp = 0u;
    for (;;) {
        sum = 0u; cnt = 0u; mine = 0u;
#pragma unroll
        for (unsigned j = 0; j < 16; ++j) { const unsigned c = xb_ld(&bar[XB_XCNT(j)]); sum += c; cnt += (c > 0u) ? 1u : 0u; mine = (j == x) ? c : mine; }
        if (sum == G) break;
        __builtin_amdgcn_s_sleep(1);
        if ((++sp & 255u) == 0u) { if (xb_ld(&bar[XB_TMO])) break; if (sp > XB_SPIN_CAP) { atomicAdd(&bar[XB_TMO], 1u); break; } }
    }
    nloc = mine > 0u ? mine : 1u; nx = cnt > 0u ? cnt : 1u;
}
__device__ __forceinline__ void xcd_barrier(unsigned* bar, volatile LAS unsigned* st, const bool leader) {
    asm volatile("s_waitcnt vmcnt(0)" ::: "memory");
    __syncthreads();
    if (leader) {
        const unsigned x = xb_xcc_id();
        __builtin_amdgcn_s_waitcnt(0);
        unsigned nloc = st[0], nx = st[1];
        if (nloc == 0u) { xcd_barrier_complete(bar, x, nloc, nx); st[0] = nloc; st[1] = nx; }
        const unsigned old = xb_add(&bar[XB_XSUB(x)], 1u);
        const unsigned gen = old / nloc;
        if (old + 1u == (gen + 1u) * nloc) {
            __builtin_amdgcn_fence(__ATOMIC_RELEASE, "agent");
            asm volatile("s_waitcnt vmcnt(0)" ::: "memory");
            const unsigned og = xb_add(&bar[XB_TOP], 1u);
            const unsigned tg = og / nx;
            if (og + 1u == (tg + 1u) * nx) xb_add(&bar[XB_TOPGEN], 1u);
            else XB_SPIN(xb_ld(&bar[XB_TOPGEN]) == tg, bar);
            __builtin_amdgcn_fence(__ATOMIC_ACQUIRE, "agent");
            xb_add(&bar[XB_XGEN(x)], 1u);
            asm volatile("s_waitcnt vmcnt(0)" ::: "memory");
        } else {
            XB_SPIN(xb_ld(&bar[XB_XGEN(x)]) == gen, bar);
            __builtin_amdgcn_fence(__ATOMIC_ACQUIRE, "agent");
            asm volatile("s_waitcnt vmcnt(0)" ::: "memory");
        }
    }
    __syncthreads();
}

__global__ void __launch_bounds__(512, 2) fwd_megakernel(Params p) {
    extern __shared__ __attribute__((aligned(16))) unsigned char lds[];
    cg::grid_group grid = cg::this_grid();
    LAS unsigned char* L = (LAS unsigned char*)lds;
    const int wave = __builtin_amdgcn_readfirstlane((int)threadIdx.x >> 6);
#define lane lane_id()
#define tid (wave * 64 + lane_id())
    const int G = gridDim.x, bx = blockIdx.x;
    if (threadIdx.x < 2) ((volatile LAS unsigned*)(L + MISC_OFF))[threadIdx.x] = 0u;
    __syncthreads();
    const int vcu = (G % 8 == 0) ? (bx % 8) * (G / 8) + bx / 8 : bx;
    const int gw = vcu * 8 + wave, NGW = G * 8;
    typedef const __attribute__((address_space(4))) Params* KP;
    const KP kp = (KP)__builtin_amdgcn_kernarg_segment_ptr();
#define PP() KP q = kp; asm volatile("" : "+s"(q)); unsigned char* const ws = q->ws; (void)ws
#define mod ((float*)(ws + WS_MOD))
#define rope ((float*)(ws + WS_ROPE))
#define Win ((bf16_t*)(ws + WS_WIN))
#define Wao ((bf16_t*)(ws + WS_WAO))
#define Wpin ((bf16_t*)(ws + WS_WPIN))
#define SWv ((float*)(ws + WS_SW))
#define RSS ((float*)(ws + WS_RSS))
#define Wpo ((bf16_t*)(ws + WS_WPO))
#define Hb ((bf16_t*)(ws + WS_H))
#define Qb ((bf16_t*)(ws + WS_Q))
#define Kb ((bf16_t*)(ws + WS_K))
#define Vb ((bf16_t*)(ws + WS_V))
#define Gb ((bf16_t*)(ws + WS_G))
    const int lo = kp->ph_lo, hi = kp->ph_hi;
#ifndef PHASE_MASK
#define PHASE_MASK 0xff
#endif
#define IN(k) (((PHASE_MASK >> (k)) & 1) && lo <= (k) && (k) < hi)
#define SEAM(k) do { if (IN(k) && IN((k) + 1)) { unsigned* bar_ = (unsigned*)(kp->ws + WS_BAR); \
        if ((k) == 0) { grid.sync(); if (tid == 0) (void)xb_add(&bar_[XB_XCNT(xb_xcc_id())], 1u); } \
        else xcd_barrier(bar_, (volatile LAS unsigned*)(L + MISC_OFF), tid == 0); } } while (0)

    if (IN(0)) { PP();
        LAS float* scr = (LAS float*)(L + wave * 16384);
        constexpr int I_IN = 16 * (N_IN / 32), I_AO = 16 * 32, I_PIN = 16 * 32, I_PO = 16 * 32, NITEMS = I_IN + I_AO + I_PIN + I_PO;
        for (int it = gw; it < NITEMS; it += NGW) {
            int r = it;
            if (r < I_IN) { p0_transpose_item(q->attn_w_in, DM, N_IN, N_IN, Win, 0, scr, r, lane); continue; } r -= I_IN;
            if (r < I_AO) { p0_transpose_item(q->attn_w_out, DM, DM, DM, Wao, 0, scr, r, lane); continue; } r -= I_AO;
            if (r < I_PIN) { p0_transpose_item(q->pool_w_in + DM, DM, DM, 2 * DM, Wpin, DM, scr, r, lane); continue; } r -= I_PIN;
            p0_transpose_item(q->pool_w_out, DM, DM, DM, Wpo, 0, scr, r, lane);
        }
        for (int e = gw * 64 + lane; e < M; e += NGW * 64) RSS[e] = 0.f;
        if (bx == 0) for (int e = tid; e < XCD_BAR_WORDS; e += 512) ((unsigned*)(ws + WS_BAR))[e] = 0u;
        for (int e = gw * 64 + lane; e < SEQ * 64; e += NGW * 64) {
            const int s = e >> 6, pi = e & 63, fi = pi & 31; const float pos = (float)(pi < 32 ? (s >> 6) : (s & 63));
            const double inv = exp2(-(double)(2 * fi) / 64.0 * 13.287712379549449);
            const double ang = (double)((float)((double)pos * (double)(float)inv));
            const double k = rint(ang * 0.15915494309189535); const float rr = (float)(ang - k * 6.283185307179586);
            float sn, cn; __sincosf(rr, &sn, &cn);
            rope[2 * e] = cn; rope[2 * e + 1] = sn;
        }
        __syncthreads();
        LAS float* sc = (LAS float*)L;
        LAS float* part = (LAS float*)(L + 65536);
        for (int e = tid; e < NB * DM; e += 512) { const int b = e >> 10, k = e & 1023; const float cv = (b < NBP) ? q->cp[b * DM + k] : q->cs[(b - NBP) * DM + k]; sc[e] = cv / (1.0f + expf(-cv)); }
        __syncthreads();
        for (int it = bx; it < 2 * 96; it += G) {
            const int i = it / 96, n0 = (it % 96) * 32, col = lane & 31, kh = lane >> 5;
            const float* wp = q->ada_w + (size_t)i * DM * 3072 + n0 + col;
            float acc[NB];
#pragma unroll
            for (int b = 0; b < NB; ++b) acc[b] = 0.f;
#pragma unroll 4
            for (int kk = 0; kk < 64; ++kk) { const int k = wave * 128 + 2 * kk + kh; const float wv = wp[(size_t)k * 3072];
#pragma unroll
                for (int b = 0; b < NB; ++b) acc[b] += sc[b * DM + k] * wv; }
#pragma unroll
            for (int b = 0; b < NB; ++b) { acc[b] += __shfl_xor(acc[b], 32); if (lane < 32) part[(wave * NB + b) * 32 + col] = acc[b]; }
            __syncthreads();
            if (tid < NB * 32) { const int b = tid >> 5, c2 = tid & 31; float s = q->ada_b[i * 3072 + n0 + c2];
#pragma unroll
                for (int w = 0; w < 8; ++w) s += part[(w * NB + b) * 32 + c2];
                mod[(size_t)(b * 2 + i) * 3072 + n0 + c2] = s; }
            __syncthreads();
        }
        { LAS float* As = (LAS float*)L;
          LAS float* Bs = (LAS float*)(L + 16384);
          const int t_ = tid, d = t_ & 63, kq = t_ >> 6;
          for (int it = bx; it < 256; it += G) {
              const int gi = it >> 6, k0 = ((it >> 2) & 15) * 64, d0 = (it & 3) * 64;
              float acc[8];
#pragma unroll
              for (int i = 0; i < 8; ++i) acc[i] = 0.f;
              for (int c0 = 0; c0 < 256; c0 += 32) {
#pragma unroll
                  for (int j = 0; j < 4; ++j) { const int e = t_ + 512 * j; As[(e >> 5) * 33 + (e & 31)] = q->pool_w_in[(size_t)(k0 + (e >> 5)) * 2048 + gi * 256 + c0 + (e & 31)];
                      Bs[e] = q->pool_w_group[(size_t)gi * 65536 + (size_t)(c0 + (e >> 6)) * 256 + d0 + (e & 63)]; }
                  __syncthreads();
#pragma unroll 8
                  for (int cc = 0; cc < 32; ++cc) { const float bv = Bs[cc * 64 + d];
#pragma unroll
                      for (int i = 0; i < 8; ++i) acc[i] += As[(kq * 8 + i) * 33 + cc] * bv; }
                  __syncthreads();
              }
              u32x4 w; w.x = pk2(acc[0], acc[1]); w.y = pk2(acc[2], acc[3]); w.z = pk2(acc[4], acc[5]); w.w = pk2(acc[6], acc[7]);
              *(u32x4*)(Wpin + (size_t)(gi * 256 + d0 + d) * DM + k0 + kq * 8) = w;
          } }
    }
    SEAM(0);
    if (IN(1)) { PP();
        for (int n = gw; n < 2048; n += NGW) {
            const u32x4 w0 = *(const u32x4*)(Wpin + (size_t)n * DM + lane * 8), w1 = *(const u32x4*)(Wpin + (size_t)n * DM + 512 + lane * 8);
            for (int b = 0; b < NB; ++b) { const float* sh = mod + (size_t)(b * 2 + 1) * 3072;
                const f32x4 a0 = *(const f32x4*)(sh + lane * 8), a1 = *(const f32x4*)(sh + lane * 8 + 4), a2 = *(const f32x4*)(sh + 512 + lane * 8), a3 = *(const f32x4*)(sh + 512 + lane * 8 + 4);
                float t = a0[0] * bf_lo(w0.x) + a0[1] * bf_hi(w0.x) + a0[2] * bf_lo(w0.y) + a0[3] * bf_hi(w0.y) + a1[0] * bf_lo(w0.z) + a1[1] * bf_hi(w0.z) + a1[2] * bf_lo(w0.w) + a1[3] * bf_hi(w0.w)
                        + a2[0] * bf_lo(w1.x) + a2[1] * bf_hi(w1.x) + a2[2] * bf_lo(w1.y) + a2[3] * bf_hi(w1.y) + a3[0] * bf_lo(w1.z) + a3[1] * bf_hi(w1.z) + a3[2] * bf_lo(w1.w) + a3[3] * bf_hi(w1.w);
                t = wave_sum(t); if (lane == 0) SWv[(size_t)b * 2048 + n] = t; }
        }
        modnorm_phase(q->xp, q->xs, q->norm_g, mod, 0, Hb, gw, NGW, lane); }
    SEAM(1);
    if (IN(2)) { PP();
        pg8::Gemm g{Hb, Win, M, N_IN, DM, DM, 0}; pg8::StaticOrder S; S.init(M, N_IN, G, bx);
        pg8::EpiQKVG E{ws + WS_Q, ws + WS_K, ws + WS_V, Gb, q->qg, q->kg, rope, (LAS float*)(L + XCH_OFF)};
        pg8::gemm_phase<pg8::EpiQKVG, pg8::StaticOrder>(L, g, S, E, wave);
    }
    SEAM(2);
    if (IN(3)) { PP();
        constexpr int NU = NB * NH * (SEQ / 256);
#define UNIT(i_, b_, h_, qb_) ((G == 256) ? ((i_) < NU / 256 ? ((b_) = ((bx & 7) * (NU / 256) + (i_)) >> 3, (h_) = ((bx & 7) * (NU / 256) + (i_)) & 7, (qb_) = bx >> 3, true) : false) \
                                        : ((i_) * G + bx < NU ? ((qb_) = ((i_) * G + bx) & 31, (b_) = (((i_) * G + bx) >> 5) >> 3, (h_) = (((i_) * G + bx) >> 5) & 7, true) : false))
        att8::v8i qr[2]; int b = 0, h = 0, qb = 0;
        bool have = UNIT(0, b, h, qb);
        if (have) { const int ln = lane; att8::load_q(qr, ws + WS_Q + ((size_t)b * SEQ + (size_t)qb * 256) * DM + h * HD, wave, ln & 31, ln >> 5); }
        for (int i = 0; have; ++i) {
            int bn = 0, hn = 0, qbn = 0; const bool hn_ok = UNIT(i + 1, bn, hn, qbn);
            const size_t m0 = (size_t)b * SEQ + (size_t)qb * 256, qo = m0 * DM + h * HD, ko = (size_t)b * SEQ * KVD + (h >> 2) * HD;
            const size_t m0n = (size_t)bn * SEQ + (size_t)qbn * 256, qon = m0n * DM + hn * HD, kon = (size_t)bn * SEQ * KVD + (hn >> 2) * HD;
            att8::body(ws + WS_Q + qo, ws + WS_K + ko, ws + WS_V + (size_t)(b * 2 + (h >> 2)) * 128 * 8192, Gb + qo, Hb + qo, SEQ, (char*)lds, wave,
                       qr, i > 0, hn_ok, ws + WS_Q + qon, ws + WS_K + kon, ws + WS_V + (size_t)(bn * 2 + (hn >> 2)) * 128 * 8192);
            b = bn; h = hn; qb = qbn; have = hn_ok;
        }
#undef UNIT
    }
    SEAM(3);
    if (IN(4)) { PP();
        pg8::Gemm g{Hb, Wao, M, DM, DM, DM, 0}; pg8::StaticOrder S; S.init(M, DM, G, bx);
        pg8::EpiX1 E{q->xp, q->xs, q->out, Qb, mod, q->norm_g + DM, RSS, (LAS f32x4*)(L + XCH_OFF)};
        pg8::gemm_phase<pg8::EpiX1, pg8::StaticOrder>(L, g, S, E, wave);
    }
    SEAM(4);
    if (IN(5)) { PP();
        pg8::Gemm g{Qb, Wpin, M, 2 * DM, DM, DM, 0}; pg8::StaticOrder S; S.init(M, 2 * DM, G, bx);
        pg8::EpiPoolIn E{Hb, Gb, RSS, SWv};
        pg8::gemm_phase<pg8::EpiPoolIn, pg8::StaticOrder>(L, g, S, E, wave);
    }
    SEAM(5);
    if (IN(6)) { PP(); pool_gate_phase(Hb, Gb, q->pool_scale, Qb, (long)gw * 64 + lane, (long)NGW * 64); }
    SEAM(6);
    if (IN(7)) { PP();
        pg8::Gemm g{Qb, Wpo, M, DM, DM, DM, 0}; pg8::StaticOrder S; S.init(M, DM, G, bx);
        pg8::EpiResGate E{q->out, q->out + (size_t)MP * DM, q->out, mod, 1};
        pg8::gemm_phase<pg8::EpiResGate, pg8::StaticOrder>(L, g, S, E, wave);
    }
#undef IN
#undef SEAM
#undef lane
#undef tid
#undef PP
#undef mod
#undef rope
#undef Win
#undef Wao
#undef Wpin
#undef SWv
#undef RSS
#undef Wpo
#undef Hb
#undef Qb
#undef Kb
#undef Vb
#undef Gb
}

extern "C" void kernel_launch(void* const* d_in, const int* in_sizes, int n_in, void* d_out, int out_size, void* d_ws, size_t ws_size, hipStream_t stream) {
    static int grid = 0;
    if (grid == 0) {
        if (n_in != 15 || in_sizes[0] != MP * DM || in_sizes[1] != (M - MP) * DM || out_size != M * DM || ws_size < WS_END) {
            fprintf(stderr, "kernel_launch: shape mismatch (n_in %d, in0 %d, in1 %d, out %d, ws %zu)\n", n_in, n_in > 0 ? in_sizes[0] : -1, n_in > 1 ? in_sizes[1] : -1, out_size, ws_size); grid = -1; return; }
        int dev = 0, cus = 0, per_cu = 0;
        hipGetDevice(&dev); hipDeviceGetAttribute(&cus, hipDeviceAttributeMultiprocessorCount, dev);
        if (hipFuncSetAttribute((const void*)fwd_megakernel, hipFuncAttributeMaxDynamicSharedMemorySize, LDS_BYTES) != hipSuccess) { fprintf(stderr, "kernel_launch: hipFuncSetAttribute failed\n"); grid = -1; return; }
        if (hipOccupancyMaxActiveBlocksPerMultiprocessor(&per_cu, (const void*)fwd_megakernel, 512, LDS_BYTES) != hipSuccess || per_cu < 1) { fprintf(stderr, "kernel_launch: occupancy query gave %d\n", per_cu); per_cu = 1; }
        (void)hipGetLastError();
        grid = cus * per_cu;
    }
    if (grid < 0) return;
    Params p{};
    p.xp = (const float*)d_in[0]; p.xs = (const float*)d_in[1]; p.cp = (const float*)d_in[2]; p.cs = (const float*)d_in[3]; p.norm_g = (const float*)d_in[4];
    p.ada_w = (const float*)d_in[5]; p.ada_b = (const float*)d_in[6]; p.attn_w_in = (const float*)d_in[7]; p.qg = (const float*)d_in[8]; p.kg = (const float*)d_in[9];
    p.attn_w_out = (const float*)d_in[10]; p.pool_w_in = (const float*)d_in[11]; p.pool_w_group = (const float*)d_in[12]; p.pool_scale = (const float*)d_in[13]; p.pool_w_out = (const float*)d_in[14];
    p.out = (float*)d_out; p.ws = (unsigned char*)d_ws;
#if MK_N_LAUNCHES == 1
    p.ph_lo = 0; p.ph_hi = NPHASE;
    void* args[] = {&p};
    hipError_t e = hipLaunchCooperativeKernel((const void*)fwd_megakernel, dim3(grid), dim3(512), args, LDS_BYTES, stream);
    if (e != hipSuccess) fprintf(stderr, "kernel_launch: cooperative launch failed: %s (grid %d)\n", hipGetErrorString(e), grid);
#else
    for (int k = 0; k < NPHASE; ++k) {
        p.ph_lo = k; p.ph_hi = k + 1;
        hipLaunchKernelGGL(fwd_megakernel, dim3(grid), dim3(512), LDS_BYTES, stream, p);
    }
#endif
}
```
